# Optimizing an MI355X kernel written in HIP

```python
import math
import jax, jax.numpy as jnp
from jax import lax
import numpy as np

D_MODEL = 4096
BATCH = 2
SEQ = 4096
DEPTH = 2

CHUNK = 64
Q_BLOCK = 128
HEAD_DIM = 128
MIX_WIDTH = D_MODEL
H_SB = (MIX_WIDTH // 2) // HEAD_DIM
H_DIFF = (MIX_WIDTH // 2) // (2 * HEAD_DIM)
H_CH = (MIX_WIDTH // 2) // HEAD_DIM
H_MLA = (MIX_WIDTH // 2) // HEAD_DIM
W_SB = H_SB * HEAD_DIM
W_DIFF = H_DIFF * 2 * HEAD_DIM
W_CH = H_CH * HEAD_DIM
LEFT_CHUNKS = 8
BAND = (LEFT_CHUNKS + 1) * CHUNK
REL_CLIP = 128
Q_LORA = D_MODEL // 4
KV_LORA = D_MODEL // 8
QK_NOPE = 128
QK_ROPE = 64
V_MLA = 128
ROPE_THETA = 10000.0
D_FF = 256 * ((8 * D_MODEL // 3 + 255) // 256)
CONV_W = 3
EPS = 1e-6
NEG = -1e30
N_EVEN = (DEPTH + 1) // 2
N_ODD = DEPTH // 2
EVEN_SIZES = [W_SB, W_SB, W_SB, W_DIFF, W_DIFF, W_DIFF]
ODD_SIZES = [W_CH, W_CH, W_CH, Q_LORA, KV_LORA, QK_ROPE]
EVEN_IN = sum(EVEN_SIZES)
ODD_IN = sum(ODD_SIZES)

kernel_name = "hybrid_stickbreak_diff_chunkrel_mla_convffn"


def rmsnorm(x, g):
    xf = x.astype(jnp.float32)
    y = xf * lax.rsqrt(jnp.mean(xf * xf, axis=-1, keepdims=True) + EPS)
    return (y * g.astype(jnp.float32)).astype(x.dtype)


def split_cols(p, sizes):
    idx = np.cumsum(sizes)[:-1].tolist()
    return jnp.split(p, idx, axis=-1)


def to_blocks(a, size):
    b, s = a.shape[:2]
    return a.reshape(b, s // size, size, *a.shape[2:]).swapaxes(0, 1)


def from_blocks(o):
    nb, b, size = o.shape[:3]
    return o.swapaxes(0, 1).reshape(b, nb * size, *o.shape[3:])


def chunk_causal_mask(qpos, kpos):
    return (kpos // CHUNK)[None, :] <= (qpos // CHUNK)[:, None]


def stick_breaking_attention(q, k, v):
    s_len = q.shape[1]
    scale = 1.0 / math.sqrt(q.shape[-1])
    kpos = jnp.arange(s_len)

    def body(args):
        qb, i = args
        qpos = i * Q_BLOCK + jnp.arange(Q_BLOCK)
        z = jnp.einsum('bqhd,bkhd->bhqk', qb, k).astype(jnp.float32) * scale
        mask = kpos[None, :] < qpos[:, None]
        log_1mb = jnp.where(mask, jax.nn.log_sigmoid(-z), 0.0)
        between = lax.cumsum(log_1mb, axis=3, reverse=True) - log_1mb
        w = jnp.where(mask, jnp.exp(jax.nn.log_sigmoid(z) + between), 0.0)
        return jnp.einsum('bhqk,bkhd->bqhd', w.astype(v.dtype), v)

    out = lax.map(body, (to_blocks(q, Q_BLOCK), jnp.arange(s_len // Q_BLOCK)))
    return from_blocks(out)


def diff_attention(q1, q2, k1, k2, v, lam, lam_init, subln_g):
    s_len, n_heads = q1.shape[1], q1.shape[2]
    scale = 1.0 / math.sqrt(q1.shape[-1])
    kpos = jnp.arange(s_len)
    slopes = 2.0 ** (-8.0 * jnp.arange(1, n_heads + 1, dtype=jnp.float32) / n_heads)

    def body(args):
        qb1, qb2, i = args
        qpos = i * Q_BLOCK + jnp.arange(Q_BLOCK)
        mask = chunk_causal_mask(qpos, kpos)[None, None]
        dist = jnp.abs(qpos[:, None] - kpos[None, :]).astype(jnp.float32)
        alibi = -slopes[:, None, None] * dist
        s1 = jnp.einsum('bqhd,bkhd->bhqk', qb1, k1).astype(jnp.float32) * scale + alibi
        s2 = jnp.einsum('bqhd,bkhd->bhqk', qb2, k2).astype(jnp.float32) * scale + alibi
        p1 = jax.nn.softmax(jnp.where(mask, s1, NEG), axis=-1)
        p2 = jax.nn.softmax(jnp.where(mask, s2, NEG), axis=-1)
        p = p1 - lam * p2
        return jnp.einsum('bhqk,bkhd->bqhd', p.astype(v.dtype), v)

    out = from_blocks(lax.map(body, (to_blocks(q1, Q_BLOCK), to_blocks(q2, Q_BLOCK),
                                     jnp.arange(s_len // Q_BLOCK))))
    return rmsnorm(out, subln_g) * (1.0 - lam_init)


def chunked_relbias_attention(q, k, v, rel_bias):
    s_len = q.shape[1]
    n_chunks = s_len // CHUNK
    pad = LEFT_CHUNKS * CHUNK
    scale = 1.0 / math.sqrt(q.shape[-1])
    kp = jnp.pad(k, ((0, 0), (pad, 0), (0, 0), (0, 0)))
    vp = jnp.pad(v, ((0, 0), (pad, 0), (0, 0), (0, 0)))
    rel = jnp.arange(CHUNK)[:, None] + pad - jnp.arange(BAND)[None, :]
    bias = rel_bias[:, jnp.clip(rel, -REL_CLIP, REL_CLIP) + REL_CLIP].astype(jnp.float32)

    def body(args):
        qc, c = args
        kb = lax.dynamic_slice_in_dim(kp, c * CHUNK, BAND, axis=1)
        vb = lax.dynamic_slice_in_dim(vp, c * CHUNK, BAND, axis=1)
        kpos = (c - LEFT_CHUNKS) * CHUNK + jnp.arange(BAND)
        s = jnp.einsum('bqhd,bkhd->bhqk', qc, kb).astype(jnp.float32) * scale + bias
        s = jnp.where((kpos >= 0)[None, None, None, :], s, NEG)
        p = jax.nn.softmax(s, axis=-1)
        return jnp.einsum('bhqk,bkhd->bqhd', p.astype(vb.dtype), vb)

    out = lax.map(body, (to_blocks(q, CHUNK), jnp.arange(n_chunks)))
    return from_blocks(out)


def rope(x, cos, sin):
    half = x.shape[-1] // 2
    x1, x2 = x[..., :half], x[..., half:]
    return jnp.concatenate([x1 * cos - x2 * sin, x2 * cos + x1 * sin], axis=-1).astype(x.dtype)


def mla_attention(c_q, c_kv, k_rope_raw, q_norm_g, w_uq, kv_norm_g, w_ukv):
    b, s_len = c_q.shape[:2]
    q = (rmsnorm(c_q, q_norm_g) @ w_uq).reshape(b, s_len, H_MLA, QK_NOPE + QK_ROPE)
    q_nope, q_rope = q[..., :QK_NOPE], q[..., QK_NOPE:]
    kv = (rmsnorm(c_kv, kv_norm_g) @ w_ukv).reshape(b, s_len, H_MLA, QK_NOPE + V_MLA)
    k_nope, v = kv[..., :QK_NOPE], kv[..., QK_NOPE:]
    pos = jnp.arange(s_len, dtype=jnp.float32)
    inv_freq = ROPE_THETA ** (-jnp.arange(0, QK_ROPE, 2, dtype=jnp.float32) / QK_ROPE)
    ang = pos[:, None] * inv_freq[None, :]
    cos, sin = jnp.cos(ang), jnp.sin(ang)
    q_rope = rope(q_rope, cos[:, None, :], sin[:, None, :])
    k_rope = rope(k_rope_raw, cos, sin)
    scale = 1.0 / math.sqrt(QK_NOPE + QK_ROPE)
    kpos = jnp.arange(s_len)

    def body(args):
        qn, qr, i = args
        qpos = i * Q_BLOCK + jnp.arange(Q_BLOCK)
        s = (jnp.einsum('bqhd,bkhd->bhqk', qn, k_nope)
             + jnp.einsum('bqhr,bkr->bhqk', qr, k_rope)).astype(jnp.float32) * scale
        s = jnp.where(chunk_causal_mask(qpos, kpos)[None, None], s, NEG)
        p = jax.nn.softmax(s, axis=-1)
        return jnp.einsum('bhqk,bkhd->bqhd', p.astype(v.dtype), v)

    out = lax.map(body, (to_blocks(q_nope, Q_BLOCK), to_blocks(q_rope, Q_BLOCK),
                         jnp.arange(s_len // Q_BLOCK)))
    return from_blocks(out)


def conv_ffn(h, w_in, conv_w, conv_b, w_out):
    s_len = h.shape[1]
    u = h @ w_in
    up = jnp.pad(u, ((0, 0), (CONV_W - 1, 0), (0, 0)))
    y = conv_b + sum(conv_w[j] * up[:, j:j + s_len] for j in range(CONV_W))
    gate, val = jnp.split(y, 2, axis=-1)
    return (jax.nn.gelu(gate, approximate=True) * val) @ w_out


def even_mixer(h, w_in, w_out, diff_lambda, diff_subln_g, layer):
    b, s_len = h.shape[:2]
    sb_q, sb_k, sb_v, d_q, d_k, d_v = split_cols(h @ w_in, EVEN_SIZES)
    hd = (b, s_len, H_SB, HEAD_DIM)
    a = stick_breaking_attention(sb_q.reshape(hd), sb_k.reshape(hd), sb_v.reshape(hd))
    d_q = d_q.reshape(b, s_len, H_DIFF, 2, HEAD_DIM)
    d_k = d_k.reshape(b, s_len, H_DIFF, 2, HEAD_DIM)
    d_v = d_v.reshape(b, s_len, H_DIFF, 2 * HEAD_DIM)
    lam_init = 0.8 - 0.6 * math.exp(-0.3 * layer)
    lf = diff_lambda.astype(jnp.float32)
    lam = jnp.exp(jnp.sum(lf[0] * lf[1])) - jnp.exp(jnp.sum(lf[2] * lf[3])) + lam_init
    bo = diff_attention(d_q[:, :, :, 0], d_q[:, :, :, 1], d_k[:, :, :, 0], d_k[:, :, :, 1],
                        d_v, lam, lam_init, diff_subln_g)
    mix = jnp.concatenate([a.reshape(b, s_len, W_SB), bo.reshape(b, s_len, W_DIFF)], axis=-1)
    return mix @ w_out


def odd_mixer(h, w_in, w_out, rel_bias, q_norm_g, w_uq, kv_norm_g, w_ukv):
    b, s_len = h.shape[:2]
    c_q_, c_k_, c_v_, lat_q, lat_kv, k_rope = split_cols(h @ w_in, ODD_SIZES)
    hd = (b, s_len, H_CH, HEAD_DIM)
    c = chunked_relbias_attention(c_q_.reshape(hd), c_k_.reshape(hd), c_v_.reshape(hd), rel_bias)
    d = mla_attention(lat_q, lat_kv, k_rope, q_norm_g, w_uq, kv_norm_g, w_ukv)
    mix = jnp.concatenate([c.reshape(b, s_len, W_CH), d.reshape(b, s_len, H_MLA * V_MLA)], axis=-1)
    return mix @ w_out


def setup_inputs(seed: int = 0) -> dict:
    key = jax.random.key(seed)
    ks = jax.random.split(key, 20)
    f32 = jnp.float32

    def nrm(k, shape, scale):
        return jax.random.normal(k, shape, f32) * scale

    return {
        "x": nrm(ks[0], (BATCH, SEQ, D_MODEL), 1.0),
        "norm_g": 1.0 + nrm(ks[1], (DEPTH, 4, D_MODEL), 0.05),
        "even_w_in": nrm(ks[2], (N_EVEN, D_MODEL, EVEN_IN), D_MODEL ** -0.5),
        "even_w_out": nrm(ks[3], (N_EVEN, MIX_WIDTH, D_MODEL), MIX_WIDTH ** -0.5),
        "diff_lambda": nrm(ks[4], (N_EVEN, 4, HEAD_DIM), 0.1),
        "diff_subln_g": 1.0 + nrm(ks[5], (N_EVEN, 2 * HEAD_DIM), 0.05),
        "odd_w_in": nrm(ks[6], (N_ODD, D_MODEL, ODD_IN), D_MODEL ** -0.5),
        "odd_w_out": nrm(ks[7], (N_ODD, MIX_WIDTH, D_MODEL), MIX_WIDTH ** -0.5),
        "ch_rel_bias": nrm(ks[8], (N_ODD, H_CH, 2 * REL_CLIP + 1), 0.5),
        "mla_q_norm_g": 1.0 + nrm(ks[9], (N_ODD, Q_LORA), 0.05),
        "mla_w_uq": nrm(ks[10], (N_ODD, Q_LORA, H_MLA * (QK_NOPE + QK_ROPE)), Q_LORA ** -0.5),
        "mla_kv_norm_g": 1.0 + nrm(ks[11], (N_ODD, KV_LORA), 0.05),
        "mla_w_ukv": nrm(ks[12], (N_ODD, KV_LORA, H_MLA * (QK_NOPE + V_MLA)), KV_LORA ** -0.5),
        "ffn_w_in": nrm(ks[13], (DEPTH, D_MODEL, 2 * D_FF), D_MODEL ** -0.5),
        "ffn_conv_w": nrm(ks[14], (DEPTH, CONV_W, 2 * D_FF), CONV_W ** -0.5),
        "ffn_conv_b": nrm(ks[15], (DEPTH, 2 * D_FF), 0.01),
        "ffn_w_out": nrm(ks[16], (DEPTH, D_FF, D_MODEL), D_FF ** -0.5),
    }


def reference(x, norm_g, even_w_in, even_w_out, diff_lambda, diff_subln_g,
              odd_w_in, odd_w_out, ch_rel_bias, mla_q_norm_g, mla_w_uq,
              mla_kv_norm_g, mla_w_ukv, ffn_w_in, ffn_conv_w, ffn_conv_b, ffn_w_out):
    for layer in range(DEPTH):
        g = norm_g[layer]
        hn = rmsnorm(x, g[0])
        if layer % 2 == 0:
            i = layer // 2
            mix = even_mixer(hn, even_w_in[i], even_w_out[i], diff_lambda[i],
                             diff_subln_g[i], layer)
        else:
            i = layer // 2
            mix = odd_mixer(hn, odd_w_in[i], odd_w_out[i], ch_rel_bias[i], mla_q_norm_g[i],
                            mla_w_uq[i], mla_kv_norm_g[i], mla_w_ukv[i])
        x = x + rmsnorm(mix, g[1])
        f = conv_ffn(rmsnorm(x, g[2]), ffn_w_in[layer], ffn_conv_w[layer],
                     ffn_conv_b[layer], ffn_w_out[layer])
        x = x + rmsnorm(f, g[3])
    return x
```

```cpp
#include <hip/hip_runtime.h>
#include <cstdio>
#include <cstdint>
__device__ __forceinline__ int opaque_tid() { int t = threadIdx.x; asm volatile("" : "+v"(t)); return t; }
#ifndef GEMM_ROT
#define GEMM_ROT 0
#endif
#ifndef GEMM_WGM
#define GEMM_WGM 8
#endif
namespace pg8 {
#define PG8_LAS __attribute__((address_space(3)))
typedef unsigned short bf16_t;
typedef short bf16x8 __attribute__((ext_vector_type(8)));
typedef float f32x4 __attribute__((ext_vector_type(4)));
typedef unsigned u32x4 __attribute__((ext_vector_type(4)));
constexpr int BM = 256, BK = 64, HALF = 128, HTB = HALF * BK * 2  , STAGE_BYTES = 8 * HTB, NXCD = 8, WGM = GEMM_WGM;

__host__ __device__ __forceinline__ int lds_byte(int r, int c) { const int st = (r >> 4) * 2 + (c >> 5), rr = r & 15, cc = c & 31, ob = rr * 64 + cc * 2; return st * 1024 + (ob ^ (((ob >> 9) & 1) << 5)); }
__host__ __device__ __forceinline__ void stage_rc(int b, int& R, int& C) { const int st = b / 1024, sb = b % 1024, swz = sb ^ (((sb >> 9) & 1) << 5); R = (st >> 1) * 16 + swz / 64; C = (st & 1) * 32 + (swz % 64) / 2; }
__host__ __device__ __forceinline__ int perm32(int rho) { const int n = rho >> 4, i = rho & 15; return 8 * (i >> 2) + 4 * n + (i & 3); }

struct Unit { int pm, pn; };
struct Gemm { const bf16_t* A; const bf16_t* Bt; int M, N, K, lda, ldb; unsigned kstepB, tstepB; };

struct StaticOrder {
    int nM, nN, nwg, G, c, rot;
    __host__ __device__ __forceinline__ void init(int M, int N, int G_, int c_) { nM = M / BM; nN = N / BM; nwg = nM * nN; G = G_; c = c_; rot = GEMM_ROT ? nN / ((nM + WGM - 1) / WGM) : 0; }
    __host__ __device__ __forceinline__ bool next(int i, Unit& u) const {
        const long L = (long)i * G + c; if (L >= nwg) return false;
        int wgid = (int)L; { const int q = nwg / NXCD, r = nwg % NXCD, xcd = wgid % NXCD, off = wgid / NXCD; wgid = (xcd < r ? xcd * (q + 1) : r * (q + 1) + (xcd - r) * q) + off; }
        const int nig = WGM * nN, gid = wgid / nig, fm = gid * WGM, gsz = (nM - fm) < WGM ? (nM - fm) : WGM;
        u.pm = fm + ((wgid % nig) % gsz); u.pn = ((wgid % nig) / gsz + gid * rot) % nN; return true;
    }
    __device__ __forceinline__ void a_ready(const Unit&) const {}
    __device__ __forceinline__ void done(const Unit&) const {}
};
__device__ __forceinline__ unsigned cvt_pk_bf16(float lo, float hi) { unsigned r; asm volatile("v_cvt_pk_bf16_f32 %0, %1, %2" : "=v"(r) : "v"(lo), "v"(hi)); return r; }
struct EpiStore {
    static constexpr bool PERM = true, AFTER_DRAIN = false;
    bf16_t* O; int ldc; int skip; unsigned* km; const float* rs;
    __device__ __forceinline__ void operator()(const f32x4 (&acc)[2][2][4][2], const Unit& u, int wr, int wc, int fr, int fq) const {
        if (skip) return;
        const int row0 = u.pm * BM + wr * 64 + fr; const int col0 = u.pn * BM + wc * 32 + 8 * fq;
        float scv[2][4];
#pragma unroll
        for (int ai = 0; ai < 2; ++ai)
#pragma unroll
            for (int m = 0; m < 4; ++m) scv[ai][m] = rs ? rs[row0 + ai * HALF + m * 16] : 1.f;
#pragma unroll
        for (int ai = 0; ai < 2; ++ai)
#pragma unroll
            for (int m = 0; m < 4; ++m) { bf16_t* rowp = O + (size_t)(row0 + ai * HALF + m * 16) * ldc + col0;
                const float sc = scv[ai][m];
#pragma unroll
                for (int bj = 0; bj < 2; ++bj) { const f32x4 v0 = acc[ai][bj][m][0] * sc, v1 = acc[ai][bj][m][1] * sc;
                    u32x4 w; w.x = cvt_pk_bf16(v0[0], v0[1]); w.y = cvt_pk_bf16(v0[2], v0[3]); w.z = cvt_pk_bf16(v1[0], v1[1]); w.w = cvt_pk_bf16(v1[2], v1[3]);
                    *(u32x4*)(rowp + bj * HALF) = w; } }
        if (km && u.pn >= 32 && u.pn < 40) {
            float mx[2] = {0.f, 0.f};
#pragma unroll
            for (int ai = 0; ai < 2; ++ai)
#pragma unroll
                for (int m = 0; m < 4; ++m)
#pragma unroll
                    for (int bj = 0; bj < 2; ++bj) { const float sc = scv[ai][m]; const f32x4 v0 = acc[ai][bj][m][0] * sc, v1 = acc[ai][bj][m][1] * sc;
                        const unsigned w0 = cvt_pk_bf16(v0[0], v0[1]), w1 = cvt_pk_bf16(v0[2], v0[3]), w2 = cvt_pk_bf16(v1[0], v1[1]), w3 = cvt_pk_bf16(v1[2], v1[3]);
                        float s = 0.f;
#define SQ2(w) { const float a_ = __uint_as_float((w) << 16), b_ = __uint_as_float((w) & 0xffff0000u); s += a_ * a_ + b_ * b_; }
                        SQ2(w0) SQ2(w1) SQ2(w2) SQ2(w3)
#undef SQ2
                        s += __shfl_xor(s, 16); s += __shfl_xor(s, 32);
                        mx[bj] = fmaxf(mx[bj], s); }
#pragma unroll
            for (int bj = 0; bj < 2; ++bj) { float t = mx[bj]; t = fmaxf(t, __shfl_xor(t, 1)); t = fmaxf(t, __shfl_xor(t, 2)); t = fmaxf(t, __shfl_xor(t, 4)); t = fmaxf(t, __shfl_xor(t, 8));
                if ((threadIdx.x & 63) == 0) atomicMax(km + (((u.pm >> 4) * 16 + (u.pn - 32) * 2 + bj) * 4 + wc), __float_as_uint(t)); }
        }
    }
};


template <int CTRL> __device__ __forceinline__ float dpp1(float x) { return __builtin_bit_cast(float, __builtin_amdgcn_update_dpp(0, __builtin_bit_cast(int, x), CTRL, 0xf, 0xf, false)); }
template <int CTRL> __device__ __forceinline__ float dpp1o(float old, float x) { return __builtin_bit_cast(float, __builtin_amdgcn_update_dpp(__builtin_bit_cast(int, old), __builtin_bit_cast(int, x), CTRL, 0xf, 0xf, false)); }
template <int CTRL> __device__ __forceinline__ f32x4 dpp4o(const f32x4 old, const f32x4 v) { f32x4 r; r.x = dpp1o<CTRL>(old.x, v.x); r.y = dpp1o<CTRL>(old.y, v.y); r.z = dpp1o<CTRL>(old.z, v.z); r.w = dpp1o<CTRL>(old.w, v.w); return r; }
template <int CTRL> __device__ __forceinline__ f32x4 dpp4(const f32x4 v) { f32x4 r; r.x = dpp1<CTRL>(v.x); r.y = dpp1<CTRL>(v.y); r.z = dpp1<CTRL>(v.z); r.w = dpp1<CTRL>(v.w); return r; }
__device__ __forceinline__ float gelu_tanh_f(float x) {
    const float u_ = x * (1.f + 0.044715f * x * x);
    const float e_ = __builtin_amdgcn_exp2f(-2.f * 0.7978845608028654f * 1.4426950408889634f * u_);
    return x * __builtin_amdgcn_rcpf(1.f + e_);
}
struct EpiConv {
    static constexpr bool PERM = true, AFTER_DRAIN = false;
    bf16_t* G; int ldg; const float* rs; const float* cw; const float* cb; int ff; float* halo; PG8_LAS float* hb;
    __device__ __forceinline__ void operator()(const f32x4 (&acc)[2][2][4][2], const Unit& u, int wr, int wc, int fr_in, int fq_in) const {
        int fr = fr_in, fq = fq_in; asm volatile("" : "+v"(fr), "+v"(fq));
        const int R0 = u.pm * BM, rowl0 = wr * 64 + fr;
        float sc[2][4];
#pragma unroll
        for (int ai = 0; ai < 2; ++ai)
#pragma unroll
            for (int m = 0; m < 4; ++m) sc[ai][m] = rs[R0 + ai * HALF + rowl0 + m * 16];
        if (fr >= 14) {
#pragma unroll
            for (int ai = 0; ai < 2; ++ai)
#pragma unroll
                for (int bj = 0; bj < 2; ++bj)
#pragma unroll
                    for (int n = 0; n < 2; ++n) *(PG8_LAS f32x4*)(hb + ((((ai * 2 + wr) * 2 + (fr - 14)) * 2 + bj) * 128 + wc * 32 + fq * 8 + n * 4)) = acc[ai][bj][3][n] * sc[ai][3];
        }
        asm volatile("s_waitcnt lgkmcnt(0)" ::: "memory"); __builtin_amdgcn_s_barrier(); asm volatile("" ::: "memory");
        const int cg0 = u.pn * 128 + wc * 32 + fq * 8;
        const bool skip01 = (u.pm & 15) != 0 && wr == 0;
#pragma unroll
        for (int ai = 0; ai < 2; ++ai) {
            unsigned outp[4][2][2];
#pragma unroll
            for (int n = 0; n < 2; ++n) {
                const int cg = cg0 + 4 * n;
                const f32x4 wg0 = *(const f32x4*)(cw + cg), wg1 = *(const f32x4*)(cw + 2 * ff + cg), wg2 = *(const f32x4*)(cw + 4 * ff + cg), bg = *(const f32x4*)(cb + cg);
                const f32x4 wv0 = *(const f32x4*)(cw + ff + cg), wv1 = *(const f32x4*)(cw + 3 * ff + cg), wv2 = *(const f32x4*)(cw + 5 * ff + cg), bv = *(const f32x4*)(cb + ff + cg);
                f32x4 pg1, pg2, pv1, pv2;
                { f32x4 x14g = {0.f, 0.f, 0.f, 0.f}, x15g = x14g, x14v = x14g, x15v = x14g;
                  if (wr == 1 || ai == 1) { const int pa = wr == 1 ? ai : 0, pw = wr == 1 ? 0 : 1;
                      const PG8_LAS float* h = hb + (((pa * 2 + pw) * 2) * 2) * 128 + wc * 32 + fq * 8 + n * 4;
                      x14g = *(const PG8_LAS f32x4*)(h); x14v = *(const PG8_LAS f32x4*)(h + 128); x15g = *(const PG8_LAS f32x4*)(h + 256); x15v = *(const PG8_LAS f32x4*)(h + 384); }
                  pg1 = x15g; pv1 = x15v;
#pragma unroll
                  for (int k = 0; k < 4; ++k) { pg2[k] = fr == 0 ? x14g[k] : x15g[k]; pv2[k] = fr == 0 ? x14v[k] : x15v[k]; } }
#pragma unroll
                for (int m = 0; m < 4; ++m) {
                    const f32x4 cg_ = acc[ai][0][m][n] * sc[ai][m], cv_ = acc[ai][1][m][n] * sc[ai][m];
                    const f32x4 p1g = dpp4o<0x111>(pg1, cg_), p2g = dpp4o<0x112>(pg2, cg_), p1v = dpp4o<0x111>(pv1, cv_), p2v = dpp4o<0x112>(pv2, cv_);
                    f32x4 o_;
#pragma unroll
                    for (int k = 0; k < 4; ++k) {
                        const float yg = bg[k] + wg0[k] * p2g[k] + wg1[k] * p1g[k] + wg2[k] * cg_[k], yv = bv[k] + wv0[k] * p2v[k] + wv1[k] * p1v[k] + wv2[k] * cv_[k];
                        o_[k] = gelu_tanh_f(yg) * yv; }
                    outp[m][n][0] = cvt_pk_bf16(o_[0], o_[1]); outp[m][n][1] = cvt_pk_bf16(o_[2], o_[3]);
                    if (m < 3) { pg1 = dpp4<0x121>(cg_); pg2 = dpp4<0x122>(cg_); pv1 = dpp4<0x121>(cv_); pv2 = dpp4<0x122>(cv_); }
                }
            }
#pragma unroll
            for (int m = 0; m < 4; ++m) { u32x4 w; w.x = outp[m][0][0]; w.y = outp[m][0][1]; w.z = outp[m][1][0]; w.w = outp[m][1][1];
                if (!(ai == 0 && m == 0 && skip01 && fr < 2)) *(u32x4*)(G + (size_t)(R0 + ai * HALF + rowl0 + m * 16) * ldg + cg0) = w; }
        }
        if (wr == 0 && fr < 2) {
#pragma unroll
            for (int bj = 0; bj < 2; ++bj)
#pragma unroll
                for (int n = 0; n < 2; ++n) *(f32x4*)(halo + (size_t)(u.pm * 4 + fr) * (2 * ff) + bj * ff + cg0 + 4 * n) = acc[0][bj][0][n] * sc[0][0]; }
        if (wr == 1 && fr >= 14) {
#pragma unroll
            for (int bj = 0; bj < 2; ++bj)
#pragma unroll
                for (int n = 0; n < 2; ++n) *(f32x4*)(halo + (size_t)(u.pm * 4 + 2 + (fr - 14)) * (2 * ff) + bj * ff + cg0 + 4 * n) = acc[1][bj][3][n] * sc[1][3]; }
    }
};
template <class Epi, class Sched, bool ALIGN_EPI = false, bool SP2 = false>
__device__ __forceinline__ void gemm_phase(PG8_LAS unsigned char* lds, const Gemm g, const Sched& S, const Epi& E) {
    const int tid = opaque_tid(), wid = __builtin_amdgcn_readfirstlane(tid >> 6), lane = tid & 63, wr = wid >> 2, wc = wid & 3, fr = lane & 15, fq = lane >> 4;
    const int K = g.K, nt = K / BK;
    unsigned voffA[2], voffB[2];
#pragma unroll
    for (int i = 0; i < 2; ++i) { int R, C; stage_rc(tid * 16 + i * 8192, R, C); const int Rb = Epi::PERM ? ((R & ~31) + perm32(R & 31)) : R;
        voffA[i] = (unsigned)(R * g.lda + C) * 2u; voffB[i] = (unsigned)(Rb * g.ldb + C) * 2u; }
    const size_t kstepA = (size_t)(BK * 2), kstepB = (size_t)g.kstepB;
    const size_t hstepA = (size_t)HALF * g.lda * 2, hstepB = (size_t)HALF * g.ldb * 2;
    const size_t tstepA = 2 * hstepA, tstepB = (size_t)g.tstepB;
    const unsigned ldsw = (unsigned)wid * 1024u;
    const int aoff = lds_byte(wr * 64 + fr, fq * 8), boff = lds_byte(wc * 32 + fr, fq * 8);
#define PG8_SA(b, h) (((b) * 2 + (h)) * HTB)
#define PG8_SB(b, h) ((4 + (b) * 2 + (h)) * HTB)
#define PG8_STAGE(bufoff, gbase, voff) do { _Pragma("unroll") for (int _i = 0; _i < 2; ++_i) \
        __builtin_amdgcn_global_load_lds((const unsigned*)((const char*)(gbase) + (voff)[_i]), (PG8_LAS unsigned*)(lds + (bufoff) + ldsw + _i * 8192), 16, 0, 0); } while (0)
#define PG8_LDA(dst, b, h) do { _Pragma("unroll") for (int m = 0; m < 4; ++m) _Pragma("unroll") for (int k = 0; k < 2; ++k) dst[m][k] = *(const PG8_LAS bf16x8*)(lds + PG8_SA(b, h) + aoff + m * 2048 + k * 1024); } while (0)
#define PG8_LDB(dst, b, h) do { _Pragma("unroll") for (int n = 0; n < 2; ++n) _Pragma("unroll") for (int k = 0; k < 2; ++k) dst[n][k] = *(const PG8_LAS bf16x8*)(lds + PG8_SB(b, h) + boff + n * 2048 + k * 1024); } while (0)
#define PG8_MMA(ai, bj, At, Bt) do { __builtin_amdgcn_s_setprio(1); _Pragma("unroll") for (int m = 0; m < 4; ++m) _Pragma("unroll") for (int n = 0; n < 2; ++n) _Pragma("unroll") for (int k = 0; k < 2; ++k) \
        acc[ai][bj][m][n] = __builtin_amdgcn_mfma_f32_16x16x32_bf16(Bt[n][k], At[m][k], acc[ai][bj][m][n], 0, 0, 0); __builtin_amdgcn_s_setprio(0); } while (0)
#define PG8_WAIT_V(n) asm volatile("s_waitcnt vmcnt(" #n ")" ::: "memory")
#define PG8_WAIT_L(n) asm volatile("s_waitcnt lgkmcnt(" #n ")" ::: "memory")
#define PG8_BAR __builtin_amdgcn_s_barrier()
#define PG8_SCHED __builtin_amdgcn_sched_barrier(0)
    Unit cur, nxt; int ui = 0;
    if (!S.next(0, cur)) return;
    f32x4 acc[2][2][4][2];
#pragma unroll
    for (int a = 0; a < 2; ++a)
#pragma unroll
        for (int b = 0; b < 2; ++b)
#pragma unroll
            for (int m = 0; m < 4; ++m)
#pragma unroll
                for (int n = 0; n < 2; ++n) acc[a][b][m][n] = (f32x4){0.f, 0.f, 0.f, 0.f};
    bf16x8 At[4][2], B0[2][2], B1[2][2];
    const char* cA = (const char*)g.A + (size_t)cur.pm * tstepA; const char* cB = (const char*)g.Bt + (size_t)cur.pn * tstepB;
    S.a_ready(cur);
    if constexpr (SP2) {
        PG8_STAGE(PG8_SB(0, 0), cB, voffB); PG8_STAGE(PG8_SB(0, 1), cB + hstepB, voffB); PG8_STAGE(PG8_SA(0, 0), cA, voffA); PG8_STAGE(PG8_SA(0, 1), cA + hstepA, voffA);
        if (wr == 1) PG8_BAR;
        PG8_WAIT_V(2); PG8_BAR;
        PG8_STAGE(PG8_SB(1, 0), cB + kstepB, voffB); PG8_STAGE(PG8_SA(1, 0), cA + kstepA, voffA); PG8_STAGE(PG8_SB(1, 1), cB + hstepB + kstepB, voffB);
        PG8_WAIT_V(6); PG8_BAR;
    } else {
        PG8_STAGE(PG8_SB(0, 0), cB, voffB); PG8_STAGE(PG8_SA(0, 0), cA, voffA); PG8_STAGE(PG8_SB(0, 1), cB + hstepB, voffB); PG8_STAGE(PG8_SA(0, 1), cA + hstepA, voffA);
        if (wr == 1) PG8_BAR;
        PG8_WAIT_V(4); PG8_BAR;
        PG8_STAGE(PG8_SB(1, 0), cB + kstepB, voffB); PG8_STAGE(PG8_SA(1, 0), cA + kstepA, voffA); PG8_STAGE(PG8_SB(1, 1), cB + hstepB + kstepB, voffB);
        PG8_WAIT_V(6); PG8_BAR;
    }
    for (;;) {
        const bool has_next = S.next(ui + 1, nxt);
        const char* nA = has_next ? (const char*)g.A + (size_t)nxt.pm * tstepA : cA; const char* nB = has_next ? (const char*)g.Bt + (size_t)nxt.pn * tstepB : cB;
        for (int t = 0; t < nt; t += 2) {
            const bool last = (t == nt - 2);
            const char* a1 = cA + (size_t)(t + 1) * kstepA;
            const char* a2 = last ? nA : cA + (size_t)(t + 2) * kstepA; const char* b2 = last ? nB : cB + (size_t)(t + 2) * kstepB;
            const char* a3 = a2 + kstepA; const char* b3 = b2 + kstepB;
            if (last && has_next) S.a_ready(nxt);
            if constexpr (SP2) {
            PG8_LDB(B0, 0, 0); PG8_LDB(B1, 0, 1); PG8_SCHED; PG8_LDA(At, 0, 0); PG8_STAGE(PG8_SA(1, 1), a1 + hstepA, voffA);
            PG8_WAIT_V(8); PG8_WAIT_L(0); PG8_BAR; PG8_MMA(0, 0, At, B0); PG8_MMA(0, 1, At, B1); PG8_BAR; PG8_SCHED;
            PG8_LDA(At, 0, 1); PG8_STAGE(PG8_SB(0, 0), b2, voffB); PG8_STAGE(PG8_SB(0, 1), b2 + hstepB, voffB); PG8_STAGE(PG8_SA(0, 0), a2, voffA);
            PG8_WAIT_V(8); PG8_WAIT_L(0); PG8_BAR; PG8_MMA(1, 0, At, B0); PG8_MMA(1, 1, At, B1); PG8_BAR; PG8_SCHED;
            PG8_LDB(B0, 1, 0); PG8_LDB(B1, 1, 1); PG8_SCHED; PG8_LDA(At, 1, 0); PG8_STAGE(PG8_SA(0, 1), a2 + hstepA, voffA);
            PG8_WAIT_V(8); PG8_WAIT_L(0); PG8_BAR; PG8_MMA(0, 0, At, B0); PG8_MMA(0, 1, At, B1); PG8_BAR; PG8_SCHED;
            PG8_LDA(At, 1, 1); PG8_STAGE(PG8_SB(1, 0), b3, voffB); PG8_STAGE(PG8_SB(1, 1), b3 + hstepB, voffB); PG8_STAGE(PG8_SA(1, 0), a3, voffA);
            PG8_WAIT_V(8); PG8_WAIT_L(0); PG8_BAR; PG8_MMA(1, 0, At, B0); PG8_MMA(1, 1, At, B1); PG8_BAR; PG8_SCHED;
            } else {
            PG8_LDB(B0, 0, 0); PG8_SCHED; PG8_LDA(At, 0, 0); PG8_STAGE(PG8_SA(1, 1), a1 + hstepA, voffA);
            PG8_WAIT_L(8); PG8_BAR; PG8_WAIT_L(0); PG8_MMA(0, 0, At, B0); PG8_BAR; PG8_SCHED;
            PG8_LDB(B1, 0, 1); PG8_STAGE(PG8_SB(0, 0), b2, voffB);
            PG8_BAR; PG8_WAIT_L(0); PG8_MMA(0, 1, At, B1); PG8_BAR;
            PG8_LDA(At, 0, 1); PG8_STAGE(PG8_SA(0, 0), a2, voffA);
            PG8_BAR; PG8_WAIT_L(0); PG8_MMA(1, 0, At, B0); PG8_BAR; PG8_SCHED;
            PG8_STAGE(PG8_SB(0, 1), b2 + hstepB, voffB);
            PG8_WAIT_V(6); PG8_BAR; PG8_MMA(1, 1, At, B1); PG8_BAR;
            PG8_LDB(B0, 1, 0); PG8_SCHED; PG8_LDA(At, 1, 0); PG8_STAGE(PG8_SA(0, 1), a2 + hstepA, voffA);
            PG8_WAIT_L(8); PG8_BAR; PG8_WAIT_L(0); PG8_MMA(0, 0, At, B0); PG8_BAR; PG8_SCHED;
            PG8_LDB(B1, 1, 1); PG8_STAGE(PG8_SB(1, 0), b3, voffB);
            PG8_BAR; PG8_WAIT_L(0); PG8_MMA(0, 1, At, B1); PG8_BAR;
            PG8_LDA(At, 1, 1); PG8_STAGE(PG8_SA(1, 0), a3, voffA);
            PG8_BAR; PG8_WAIT_L(0); PG8_MMA(1, 0, At, B0); PG8_BAR; PG8_SCHED;
            PG8_STAGE(PG8_SB(1, 1), b3 + hstepB, voffB);
            PG8_WAIT_V(6); PG8_BAR; PG8_MMA(1, 1, At, B1); PG8_BAR;
            }
        }
        if constexpr (ALIGN_EPI) { if (wr == 0) PG8_BAR; }
        if constexpr (!Epi::AFTER_DRAIN) { E(acc, cur, wr, wc, fr, fq); S.done(cur); }
        if (!has_next) break;
#pragma unroll
        for (int a = 0; a < 2; ++a)
#pragma unroll
            for (int b = 0; b < 2; ++b)
#pragma unroll
                for (int m = 0; m < 4; ++m)
#pragma unroll
                    for (int n = 0; n < 2; ++n) acc[a][b][m][n] = (f32x4){0.f, 0.f, 0.f, 0.f};
        cur = nxt; cA = nA; cB = nB; ++ui;
        if constexpr (ALIGN_EPI) { if (wr == 1) PG8_BAR; }
    }
    PG8_WAIT_V(0);
    if constexpr (!ALIGN_EPI) { if (wr == 0) PG8_BAR; }
    PG8_BAR;
    if constexpr (Epi::AFTER_DRAIN) { E.fused(acc, cur, wr, wc, fr, fq, lds, wid, lane); S.done(cur); }
#undef PG8_SA
#undef PG8_SB
#undef PG8_STAGE
#undef PG8_LDA
#undef PG8_LDB
#undef PG8_MMA
#undef PG8_WAIT_V
#undef PG8_WAIT_L
#undef PG8_BAR
#undef PG8_SCHED
}
}
constexpr int NB = 2, S = 4096, D = 4096, M = NB * S;
constexpr int EVEN_IN = 12288, ODD_IN = 7744, ODD_IN_P = 7936;
constexpr int FF = 11008, FF2 = 22016;
constexpr int QLORA = 1024, KVLORA = 512, QUP_N = 3072, KVUP_N = 4096;
constexpr float EPS = 1e-6f;
constexpr int NWAVES = 8;
constexpr float LOG2E = 1.4426950408889634f, LN2 = 0.6931471805599453f;

#define GAS __attribute__((address_space(1)))
#define LAS __attribute__((address_space(3)))
typedef unsigned short bf16;
typedef unsigned v4u __attribute__((ext_vector_type(4)));
typedef unsigned v2u __attribute__((ext_vector_type(2)));
typedef float f32x4 __attribute__((ext_vector_type(4)));
typedef float f32x16 __attribute__((ext_vector_type(16)));
typedef short bf16x8 __attribute__((ext_vector_type(8)));
typedef short s16x4 __attribute__((ext_vector_type(4)));
#define LDS_WAIT() asm volatile("s_waitcnt lgkmcnt(0)" ::: "memory")
#define VM_WAIT() asm volatile("s_waitcnt vmcnt(0)" ::: "memory")
#define SBAR() __builtin_amdgcn_sched_barrier(0)

constexpr int RING_OFF = 0, RING_BYTES = 131072;
constexpr int SCR_OFF = 131072;
constexpr int AUX_OFF = 133120;
constexpr int FLAG_OFF = 134400;
constexpr int LDSCTL_OFF = 135168, MISC_OFF = LDSCTL_OFF + 64;
constexpr int HB_OFF = 136192;
constexpr int LDS_BYTES = 147456;

__device__ __forceinline__ float wave_sum(float v) {
#pragma unroll
    for (int o = 1; o < 64; o <<= 1) v += __shfl_xor(v, o);
    return v;
}
__device__ __forceinline__ unsigned cvtpk(float lo, float hi) { unsigned r; asm volatile("v_cvt_pk_bf16_f32 %0, %1, %2" : "=v"(r) : "v"(lo), "v"(hi)); return r; }
__device__ __forceinline__ float bflo(unsigned w) { return __uint_as_float(w << 16); }
__device__ __forceinline__ float bfhi(unsigned w) { return __uint_as_float(w & 0xffff0000u); }

namespace att {
constexpr int SHM_T = 16384;
#define KSWZ(row, colB) ((row) * 256 + ((colB) ^ (((row) & 7) << 4)))
#define KSWZ64(row, colB) ((row) * 128 + ((colB) ^ (((row) & 7) << 4)))
__device__ __forceinline__ int v_st(int k, int c) { const int kk = (k & ~0xC) | ((k & 4) << 1) | ((k & 8) >> 1); return ((kk >> 3) * 4 + (c >> 5)) * 512 + ((kk & 7) * 32 + (c & 31)) * 2; }
__device__ __forceinline__ int v_rd_base(int lane) { return ((lane & 3) << 3) | (((lane >> 2) & 3) << 6) | (((lane >> 4) & 1) << 5) | (((lane >> 5) & 1) << 8); }
constexpr int v_rd_off(int d0, int ks, int half) { return d0 * 512 + ks * 4096 + half * 2048; }
__device__ __forceinline__ int crow(int r, int hi) { return (r & 3) + 8 * (r >> 2) + 4 * hi; }

#define MFMA32(a, b, c) __builtin_amdgcn_mfma_f32_32x32x16_bf16((a), (b), (c), 0, 0, 0)

#define DSR128(dst, addr, off) asm volatile("ds_read_b128 %0, %1 offset:%2" : "=&v"(dst) : "v"(addr), "i"(off) : "memory")
#define LGKM(n) asm volatile("s_waitcnt lgkmcnt(" #n ")" ::: "memory")
__device__ __forceinline__ void qkt128(f32x16& p0, f32x16& p1, int kaddr  , int r32, int hi, const bf16x8* qr) {
    int kb[4];
#pragma unroll
    for (int dd = 0; dd < 4; ++dd) kb[dd] = kaddr + KSWZ(r32, (dd * 16 + hi * 8) * 2);
    bf16x8 fa[4], fb[4];
#define QK_ISSUE(F, g) do { DSR128(F[0], kb[(2 * (g)) & 3], ((2 * (g)) >> 2) * 128); DSR128(F[1], kb[(2 * (g)) & 3], ((2 * (g)) >> 2) * 128 + 8192); \
        DSR128(F[2], kb[(2 * (g) + 1) & 3], ((2 * (g) + 1) >> 2) * 128); DSR128(F[3], kb[(2 * (g) + 1) & 3], ((2 * (g) + 1) >> 2) * 128 + 8192); } while (0)
#define QK_MMA(F, g) do { p0 = MFMA32(F[0], qr[2 * (g)], p0); p1 = MFMA32(F[1], qr[2 * (g)], p1); p0 = MFMA32(F[2], qr[2 * (g) + 1], p0); p1 = MFMA32(F[3], qr[2 * (g) + 1], p1); } while (0)
    QK_ISSUE(fa, 0); QK_ISSUE(fb, 1);
    LGKM(4); SBAR(); QK_MMA(fa, 0); SBAR(); QK_ISSUE(fa, 2);
    LGKM(4); SBAR(); QK_MMA(fb, 1); SBAR(); QK_ISSUE(fb, 3);
    LGKM(4); SBAR(); QK_MMA(fa, 2); SBAR();
    LGKM(0); SBAR(); QK_MMA(fb, 3); SBAR();
#undef QK_ISSUE
#undef QK_MMA
}
__device__ __forceinline__ void qkt64(f32x16& p0, f32x16& p1, int kaddr, int r32, int hi, const bf16x8* qr) {
    bf16x8 fa[4], fb[4];
    int ka[4];
#pragma unroll
    for (int d0 = 0; d0 < 4; ++d0) ka[d0] = kaddr + KSWZ64(r32, (d0 * 16 + hi * 8) * 2);
    DSR128(fa[0], ka[0], 0); DSR128(fa[1], ka[0], 4096); DSR128(fa[2], ka[1], 0); DSR128(fa[3], ka[1], 4096);
    DSR128(fb[0], ka[2], 0); DSR128(fb[1], ka[2], 4096); DSR128(fb[2], ka[3], 0); DSR128(fb[3], ka[3], 4096);
    LGKM(4); SBAR();
    p0 = MFMA32(fa[0], qr[0], p0); p1 = MFMA32(fa[1], qr[0], p1); p0 = MFMA32(fa[2], qr[1], p0); p1 = MFMA32(fa[3], qr[1], p1);
    LGKM(0); SBAR();
    p0 = MFMA32(fb[0], qr[2], p0); p1 = MFMA32(fb[1], qr[2], p1); p0 = MFMA32(fb[2], qr[3], p0); p1 = MFMA32(fb[3], qr[3], p1);
    SBAR();
}
__device__ __forceinline__ void pv_tile(f32x16* o, int vb0, bf16x8 pa0, bf16x8 pa1, bf16x8 pa2, bf16x8 pa3) {
#define TRRD(dst, off) asm volatile("ds_read_b64_tr_b16 %0, %1 offset:%2" : "=&v"(dst) : "v"(vb0), "i"(off) : "memory")
    s16x4 A_[8], B_[8];
#define PV_ISSUE(F, d0) do { constexpr int b_ = v_rd_off(d0, 0, 0); TRRD(F[0], b_); TRRD(F[1], b_ + 2048); TRRD(F[2], b_ + 4096); TRRD(F[3], b_ + 6144); \
        TRRD(F[4], b_ + 8192); TRRD(F[5], b_ + 10240); TRRD(F[6], b_ + 12288); TRRD(F[7], b_ + 14336); } while (0)
#define PV_MMA(F, d0) do { \
        o[d0] = MFMA32(pa0, ((bf16x8){F[0][0], F[0][1], F[0][2], F[0][3], F[1][0], F[1][1], F[1][2], F[1][3]}), o[d0]); \
        o[d0] = MFMA32(pa1, ((bf16x8){F[2][0], F[2][1], F[2][2], F[2][3], F[3][0], F[3][1], F[3][2], F[3][3]}), o[d0]); \
        o[d0] = MFMA32(pa2, ((bf16x8){F[4][0], F[4][1], F[4][2], F[4][3], F[5][0], F[5][1], F[5][2], F[5][3]}), o[d0]); \
        o[d0] = MFMA32(pa3, ((bf16x8){F[6][0], F[6][1], F[6][2], F[6][3], F[7][0], F[7][1], F[7][2], F[7][3]}), o[d0]); } while (0)
    PV_ISSUE(A_, 0); PV_ISSUE(B_, 1);
    LGKM(8); SBAR(); PV_MMA(A_, 0); SBAR(); PV_ISSUE(A_, 2);
    LGKM(8); SBAR(); PV_MMA(B_, 1); SBAR(); PV_ISSUE(B_, 3);
    LGKM(8); SBAR(); PV_MMA(A_, 2); SBAR();
    LGKM(0); SBAR(); PV_MMA(B_, 3); SBAR();
#undef PV_ISSUE
#undef PV_MMA
#undef TRRD
}
__device__ __forceinline__ float swap_other(float x, int hi) {
    auto rr = __builtin_amdgcn_permlane32_swap(__float_as_uint(x), __float_as_uint(x), false, false);
    return __uint_as_float(hi ? rr[0] : rr[1]);
}
__device__ __forceinline__ void pack_p(const f32x16& p0, const f32x16& p1, bf16x8& pa0, bf16x8& pa1, bf16x8& pa2, bf16x8& pa3) {
#define PK4(P, B_, OUT) do { unsigned a0 = cvtpk(P[B_+0], P[B_+1]), a1 = cvtpk(P[B_+2], P[B_+3]); \
        unsigned b0 = cvtpk(P[B_+4], P[B_+5]), b1 = cvtpk(P[B_+6], P[B_+7]); \
        auto r0 = __builtin_amdgcn_permlane32_swap(a0, b0, false, false); auto r1 = __builtin_amdgcn_permlane32_swap(a1, b1, false, false); \
        v4u w = {r0[0], r1[0], r0[1], r1[1]}; OUT = __builtin_bit_cast(bf16x8, w); } while (0)
    PK4(p0, 0, pa0); PK4(p0, 8, pa1); PK4(p1, 0, pa2); PK4(p1, 8, pa3);
#undef PK4
}
__device__ __forceinline__ void osm(f32x16& p0, f32x16& p1, float& m_reg, float& l_reg, float& alpha, bf16x8& pa0, bf16x8& pa1, bf16x8& pa2, bf16x8& pa3) {
    constexpr float THR2 = 11.5f;
    float pmax = p0[0];
#pragma unroll
    for (int r = 1; r < 16; ++r) pmax = fmaxf(pmax, p0[r]);
#pragma unroll
    for (int r = 0; r < 16; ++r) pmax = fmaxf(pmax, p1[r]);
    { auto rr = __builtin_amdgcn_permlane32_swap(__float_as_uint(pmax), __float_as_uint(pmax), false, false);
      pmax = fmaxf(__uint_as_float(rr[0]), __uint_as_float(rr[1])); }
    float mn;
    if (__all(pmax - m_reg <= THR2)) { mn = m_reg; alpha = 1.f; }
    else { mn = fmaxf(m_reg, pmax); alpha = __builtin_amdgcn_exp2f(m_reg - mn); m_reg = mn; }
    float ps = 0.f;
#pragma unroll
    for (int r = 0; r < 16; ++r) { p0[r] = __builtin_amdgcn_exp2f(p0[r] - mn); ps += p0[r]; }
#pragma unroll
    for (int r = 0; r < 16; ++r) { p1[r] = __builtin_amdgcn_exp2f(p1[r] - mn); ps += p1[r]; }
    { auto rr = __builtin_amdgcn_permlane32_swap(__float_as_uint(ps), __float_as_uint(ps), false, false);
      ps = __uint_as_float(rr[0]) + __uint_as_float(rr[1]); }
    l_reg = l_reg * alpha + ps;
    pack_p(p0, p1, pa0, pa1, pa2, pa3);
}
__device__ __forceinline__ void rescale_o(f32x16* o, float alpha, LAS float* al_l, int r32, int hi) {
    if (__any(alpha < 1.f)) {
        if (hi == 0) al_l[r32] = alpha;
        LDS_WAIT();
#pragma unroll
        for (int r = 0; r < 16; ++r) { const float a = al_l[crow(r, hi)];
#pragma unroll
            for (int d = 0; d < 4; ++d) o[d][r] *= a; }
        LDS_WAIT();
    }
}
__device__ __forceinline__ void store_o(const f32x16* o, bf16* Ow  , int ld, int r32, int hi) {
#pragma unroll
    for (int r = 0; r < 16; ++r) { const int orow = crow(r, hi);
#pragma unroll
        for (int d0 = 0; d0 < 4; ++d0) { const float v = o[d0][r]; const float vn = __shfl_xor(v, 1);
            if ((r32 & 1) == 0) *(unsigned*)(Ow + (size_t)orow * ld + d0 * 32 + r32) = cvtpk(v, vn); } }
}


__device__ __forceinline__ void sb_weights(f32x16& p0, f32x16& p1, float& carry, bool diag, int kb, int tpos, int hi) {
    const float sc_ = 0.08838834764831845f;
    f32x16 L0, L1;
#pragma unroll
    for (int r = 0; r < 16; ++r) {
        float z0 = p0[r] * sc_, z1 = p1[r] * sc_;
        const float e0 = __builtin_amdgcn_exp2f(-fabsf(z0) * LOG2E), e1 = __builtin_amdgcn_exp2f(-fabsf(z1) * LOG2E);
        float l0 = -(fmaxf(z0, 0.f) + __builtin_amdgcn_logf(1.f + e0) * LN2), l1 = -(fmaxf(z1, 0.f) + __builtin_amdgcn_logf(1.f + e1) * LN2);
        if (diag) { const int k0 = kb + crow(r, hi);
            if (k0 >= tpos) { l0 = 0.f; z0 = -__builtin_inff(); }
            if (k0 + 32 >= tpos) { l1 = 0.f; z1 = -__builtin_inff(); } }
        p0[r] = z0; p1[r] = z1; L0[r] = l0; L1[r] = l1;
    }
    float own[8], oth[8], eown[8];
#pragma unroll
    for (int g = 0; g < 4; ++g) {
        L0[4 * g + 2] += L0[4 * g + 3]; L0[4 * g + 1] += L0[4 * g + 2]; L0[4 * g] += L0[4 * g + 1]; own[g] = L0[4 * g];
        L1[4 * g + 2] += L1[4 * g + 3]; L1[4 * g + 1] += L1[4 * g + 2]; L1[4 * g] += L1[4 * g + 1]; own[4 + g] = L1[4 * g];
    }
#pragma unroll
    for (int k = 0; k < 8; ++k) oth[k] = swap_other(own[k], hi);
    float run = carry;
#pragma unroll
    for (int k = 7; k >= 0; --k) {
        const float A_ = hi ? oth[k] : own[k], B_ = hi ? own[k] : oth[k];
        const float eB = run; run += B_; const float eA = run; run += A_;
        eown[k] = hi ? eB : eA;
    }
    carry = run;
#pragma unroll
    for (int r = 0; r < 16; ++r) {
        p0[r] = __builtin_amdgcn_exp2f((p0[r] + L0[r] + eown[r >> 2]) * LOG2E);
        p1[r] = __builtin_amdgcn_exp2f((p1[r] + L1[r] + eown[4 + (r >> 2)]) * LOG2E);
    }
}

enum { MODE_MLA = 0, MODE_CH = 1, MODE_SB = 2 };
struct StdArgs {
    const bf16* Q; int ldq, qcol;
    const bf16* K; int ldk, kcol;
    const bf16* V; int ldv, vcol;
    const bf16* KR;
    const float* TAB;
    const float* bias;
    bf16* O; int ocol;
};
template <int MODE>
__device__ __forceinline__ void std_unit(LAS char* lds, const StdArgs& A, int b, int qb) {
    const int tid = opaque_tid(), wid = __builtin_amdgcn_readfirstlane(tid >> 6), lane = tid & 63, r32 = lane & 31, hi = lane >> 5;
    const int ldsbase = (int)(unsigned)(size_t)lds;
    constexpr int K_OFF = 0, V_OFF = 32768, KR_OFF = 65536;
    LAS float* scr = (LAS float*)(lds + SCR_OFF) + wid * 64; LAS float* li_l = scr; LAS float* al_l = scr + 32;
    const int P0 = qb * 256;
    const size_t rowb = (size_t)b * S;
    const int tpos = P0 + wid * 32 + r32;
    int jstart, jstep, NT, jlo_w;
    const int cw = 4 * qb + (wid >> 1);
    if (MODE == MODE_MLA) { jstart = 0; jstep = 1; NT = 4 * qb + 4; jlo_w = 0; }
    else if (MODE == MODE_CH) { jstart = 4 * qb - 8 < 0 ? 0 : 4 * qb - 8; jstep = 1; NT = 4 * qb + 4 - jstart; jlo_w = cw - 8; }
    else { jstart = 4 * qb + 3; jstep = -1; NT = 4 * qb + 4; jlo_w = 0; }
    constexpr int NQ = (MODE == MODE_MLA) ? 12 : 8;
    bf16x8 qr[NQ];
    { const bf16* qp = A.Q + (rowb + tpos) * (size_t)A.ldq + A.qcol + hi * 8;
#pragma unroll
      for (int d0 = 0; d0 < 8; ++d0) qr[d0] = *(const bf16x8*)(qp + d0 * 16);
      if constexpr (MODE == MODE_MLA) {
          v4u e[4];
#pragma unroll
          for (int k = 0; k < 4; ++k) e[k] = *(const v4u*)(qp + 128 + k * 16);
#pragma unroll
          for (int kk = 0; kk < 2; ++kk) { v4u o1, o2;
#pragma unroll
              for (int w = 0; w < 4; ++w) { const unsigned a = e[kk][w], c = e[kk + 2][w];
                  const int i0 = kk * 16 + hi * 8 + 2 * w;
                  const f32x4 cs = *(const f32x4*)(A.TAB + ((size_t)tpos * 32 + i0) * 2);
                  const float x1a = bflo(a), x1b = bfhi(a), x2a = bflo(c), x2b = bfhi(c);
                  o1[w] = cvtpk(x1a * cs[0] - x2a * cs[1], x1b * cs[2] - x2b * cs[3]);
                  o2[w] = cvtpk(x2a * cs[0] + x1a * cs[1], x2b * cs[2] + x1b * cs[3]); }
              qr[8 + kk] = __builtin_bit_cast(bf16x8, o1); qr[10 + kk] = __builtin_bit_cast(bf16x8, o2); }
      } }
    const int sr = tid >> 4, sc = (tid & 15) * 8;
    const int kws = KSWZ(sr, sc * 2), vst0 = v_st(sr, sc), vst1 = v_st(32 + sr, sc);
    const int rr_r = tid >> 3, rr_c = (tid & 7) * 8, krs = KSWZ64(rr_r, rr_c * 2);
    const bf16* Kg = A.K + rowb * (size_t)A.ldk + A.kcol + sc; const bf16* Vg = A.V + rowb * (size_t)A.ldv + A.vcol + sc;
    const bf16* KRg = A.KR + rowb * 64 + rr_c;
    bf16x8 st_k0, st_k1, st_v0, st_v1, st_r;
#define SLOAD(j) do { const size_t k0_ = (size_t)(j) * 64; \
        st_k0 = *(const bf16x8*)(Kg + (k0_ + sr) * A.ldk); st_k1 = *(const bf16x8*)(Kg + (k0_ + 32 + sr) * A.ldk); \
        st_v0 = *(const bf16x8*)(Vg + (k0_ + sr) * A.ldv); st_v1 = *(const bf16x8*)(Vg + (k0_ + 32 + sr) * A.ldv); \
        if constexpr (MODE == MODE_MLA) st_r = *(const bf16x8*)(KRg + (k0_ + rr_r) * 64); } while (0)
#define SWRITE(bf) do { *(LAS bf16x8*)(lds + K_OFF + (bf) * SHM_T + kws) = st_k0; *(LAS bf16x8*)(lds + K_OFF + (bf) * SHM_T + kws + 32 * 256) = st_k1; \
        *(LAS bf16x8*)(lds + V_OFF + (bf) * SHM_T + vst0) = st_v0; *(LAS bf16x8*)(lds + V_OFF + (bf) * SHM_T + vst1) = st_v1; \
        if constexpr (MODE == MODE_MLA) *(LAS bf16x8*)(lds + KR_OFF + (bf) * 8192 + krs) = st_r; } while (0)
    if constexpr (MODE == MODE_CH) { LAS float* bt = (LAS float*)(lds + AUX_OFF); if (tid < 257) bt[tid] = A.bias[tid] * LOG2E; }
    float m_reg = -1e30f, l_reg = 0.f, carry = 0.f;
    bool wave_done = false;
    f32x16 o[4];
#pragma unroll
    for (int d = 0; d < 4; ++d)
#pragma unroll
        for (int r = 0; r < 16; ++r) o[d][r] = 0.f;
    SLOAD(jstart); VM_WAIT(); SWRITE(0); __syncthreads();
    for (int i = 0; i < NT; ++i) {
        const int j = jstart + i * jstep, bf = i & 1;
        if (i + 1 < NT) SLOAD(j + jstep);
        if (j >= jlo_w && j <= cw && !wave_done) {
            f32x16 p0, p1;
#pragma unroll
            for (int r = 0; r < 16; ++r) { p0[r] = 0.f; p1[r] = 0.f; }
            qkt128(p0, p1, ldsbase + K_OFF + bf * SHM_T, r32, hi, qr);
            if constexpr (MODE == MODE_MLA) qkt64(p0, p1, ldsbase + KR_OFF + bf * 8192, r32, hi, qr + 8);
            bf16x8 pa0, pa1, pa2, pa3;
            if constexpr (MODE == MODE_SB) {
                sb_weights(p0, p1, carry, j == cw, j * 64, tpos, hi);
                pack_p(p0, p1, pa0, pa1, pa2, pa3);
                wave_done = __all(carry < -88.f);
            } else {
                if constexpr (MODE == MODE_MLA) { const float C2 = 0.07216878364870322f * LOG2E;
#pragma unroll
                    for (int r = 0; r < 16; ++r) { p0[r] *= C2; p1[r] *= C2; } }
                else { const float C2 = 0.08838834764831845f * LOG2E; const LAS float* bt = (const LAS float*)(lds + AUX_OFF);
                    if (j <= cw - 3) { const float bc = bt[256];
#pragma unroll
                        for (int r = 0; r < 16; ++r) { p0[r] = p0[r] * C2 + bc; p1[r] = p1[r] * C2 + bc; } }
                    else { const int dq = tpos - j * 64 - 4 * hi + 128;
#pragma unroll
                        for (int r = 0; r < 16; ++r) { const int c = (r & 3) + 8 * (r >> 2);
                            int i0 = dq - c, i1 = dq - c - 32; i0 = i0 < 0 ? 0 : (i0 > 256 ? 256 : i0); i1 = i1 < 0 ? 0 : (i1 > 256 ? 256 : i1);
                            p0[r] = p0[r] * C2 + bt[i0]; p1[r] = p1[r] * C2 + bt[i1]; } } }
                float alpha;
                osm(p0, p1, m_reg, l_reg, alpha, pa0, pa1, pa2, pa3);
                rescale_o(o, alpha, al_l, r32, hi);
            }
            pv_tile(o, ldsbase + V_OFF + bf * SHM_T + v_rd_base(lane), pa0, pa1, pa2, pa3);
        }
        if constexpr (MODE == MODE_SB) { if (lane == 0) ((LAS int*)(lds + FLAG_OFF))[bf * 8 + wid] = wave_done ? 1 : 0; }
        if (i + 1 < NT) { VM_WAIT(); SWRITE(bf ^ 1); }
        __syncthreads();
        if constexpr (MODE == MODE_SB) { const LAS int* fl = (const LAS int*)(lds + FLAG_OFF) + bf * 8; int alld = 1;
#pragma unroll
            for (int w = 0; w < 8; ++w) alld &= fl[w];
            if (alld) break; }
    }
#undef SLOAD
#undef SWRITE
    if constexpr (MODE != MODE_SB) {
        if (hi == 0) li_l[r32] = l_reg;
        LDS_WAIT();
#pragma unroll
        for (int r = 0; r < 16; ++r) { const float rl = __builtin_amdgcn_rcpf(li_l[crow(r, hi)]);
#pragma unroll
            for (int d = 0; d < 4; ++d) o[d][r] *= rl; }
    }
    store_o(o, A.O + (rowb + P0 + wid * 32) * (size_t)D + A.ocol, D, r32, hi);
}

__device__ __forceinline__ void diff_unit(LAS char* lds, const bf16* QKV, const float* gsub, const unsigned* km, float lam, bf16* MIX, int b, int hd, int c) {
    const int tid = opaque_tid(), wid = __builtin_amdgcn_readfirstlane(tid >> 6), lane = tid & 63, r32 = lane & 31, hi = lane >> 5;
    const int ldsbase = (int)(unsigned)(size_t)lds;
    const int s = wid >> 2, v = (wid >> 1) & 1, g = wid & 1;
    LAS float* scr = (LAS float*)(lds + SCR_OFF) + wid * 64; LAS float* li_l = scr; LAS float* al_l = scr + 32;
    const int P0 = c * 64, tpos = P0 + g * 32 + r32; const size_t rowb = (size_t)b * S;
    const float slope2 = __builtin_amdgcn_exp2f(-(float)(hd + 1)) * LOG2E;
    const float C2 = 0.08838834764831845f * LOG2E;
    bf16x8 qr[8];
    { const bf16* qp = QKV + (rowb + tpos) * (size_t)EVEN_IN + 6144 + hd * 256 + s * 128 + hi * 8;
#pragma unroll
      for (int d0 = 0; d0 < 8; ++d0) qr[d0] = *(const bf16x8*)(qp + d0 * 16); }
    float qk2;
    { float ss = 0.f;
#pragma unroll
      for (int d0 = 0; d0 < 8; ++d0) { const v4u w = __builtin_bit_cast(v4u, qr[d0]);
#pragma unroll
          for (int k = 0; k < 4; ++k) { const float a_ = bflo(w[k]), b_ = bfhi(w[k]); ss += a_ * a_ + b_ * b_; } }
      ss += swap_other(ss, hi);
      const unsigned* kp = km + ((b * 16 + hd * 2 + s) * 4);
      const float k2 = __uint_as_float(kp[0]) + __uint_as_float(kp[1]) + __uint_as_float(kp[2]) + __uint_as_float(kp[3]);
      qk2 = sqrtf(ss) * sqrtf(k2) * C2 * 1.001f + 0.01f; }
    const int sr = tid >> 4, sc = (tid & 15) * 8;
    const int kws = KSWZ(sr, sc * 2), vst0 = v_st(sr, sc), vst1 = v_st(32 + sr, sc);
    const bf16* Kg = QKV + rowb * (size_t)EVEN_IN + 8192 + hd * 256 + sc; const bf16* Vg = QKV + rowb * (size_t)EVEN_IN + 10240 + hd * 256 + sc;
    bf16x8 st[8];
#define SLOAD(j) do { const size_t k0_ = (size_t)(j) * 64; const bf16* ka = Kg + (k0_ + sr) * EVEN_IN; const bf16* kb_ = Kg + (k0_ + 32 + sr) * EVEN_IN; \
        const bf16* va = Vg + (k0_ + sr) * EVEN_IN; const bf16* vb_ = Vg + (k0_ + 32 + sr) * EVEN_IN; \
        st[0] = *(const bf16x8*)ka; st[1] = *(const bf16x8*)kb_; st[2] = *(const bf16x8*)(ka + 128); st[3] = *(const bf16x8*)(kb_ + 128); \
        st[4] = *(const bf16x8*)va; st[5] = *(const bf16x8*)vb_; st[6] = *(const bf16x8*)(va + 128); st[7] = *(const bf16x8*)(vb_ + 128); } while (0)
#define SWRITE(bf) do { LAS char* k1 = lds + (bf) * SHM_T; LAS char* k2 = lds + 32768 + (bf) * SHM_T; LAS char* va_ = lds + 65536 + (bf) * SHM_T; LAS char* vb2 = lds + 98304 + (bf) * SHM_T; \
        *(LAS bf16x8*)(k1 + kws) = st[0]; *(LAS bf16x8*)(k1 + kws + 32 * 256) = st[1]; *(LAS bf16x8*)(k2 + kws) = st[2]; *(LAS bf16x8*)(k2 + kws + 32 * 256) = st[3]; \
        *(LAS bf16x8*)(va_ + vst0) = st[4]; *(LAS bf16x8*)(va_ + vst1) = st[5]; *(LAS bf16x8*)(vb2 + vst0) = st[6]; *(LAS bf16x8*)(vb2 + vst1) = st[7]; } while (0)
    float m_reg = -1e30f, l_reg = 0.f;
    f32x16 o[4];
#pragma unroll
    for (int d = 0; d < 4; ++d)
#pragma unroll
        for (int r = 0; r < 16; ++r) o[d][r] = 0.f;
    SLOAD(c); VM_WAIT(); SWRITE(0); __syncthreads();
    for (int i = 0; i <= c; ++i) {
        const int j = c - i, bf = i & 1;
        if (j > 0) SLOAD(j - 1);
        {
            f32x16 p0, p1;
#pragma unroll
            for (int r = 0; r < 16; ++r) { p0[r] = 0.f; p1[r] = 0.f; }
            qkt128(p0, p1, ldsbase + (s * 2 + bf) * SHM_T, r32, hi, qr);
            const float fdq = (float)(tpos - j * 64 - 4 * hi);
#pragma unroll
            for (int r = 0; r < 16; ++r) { const float cr = (float)((r & 3) + 8 * (r >> 2));
                p0[r] = p0[r] * C2 - slope2 * fabsf(fdq - cr); p1[r] = p1[r] * C2 - slope2 * fabsf(fdq - cr - 32.f); }
            bf16x8 pa0, pa1, pa2, pa3; float alpha;
            osm(p0, p1, m_reg, l_reg, alpha, pa0, pa1, pa2, pa3);
            rescale_o(o, alpha, al_l, r32, hi);
            pv_tile(o, ldsbase + 65536 + (v * 2 + bf) * SHM_T + v_rd_base(lane), pa0, pa1, pa2, pa3);
        }
        { const float ub = qk2 - slope2 * (float)(tpos - (j * 64 - 1));
          const bool stop_w = __all(ub - m_reg < -60.f);
          if (lane == 0) ((LAS int*)(lds + FLAG_OFF))[bf * 8 + wid] = stop_w ? 1 : 0; }
        if (j > 0) { VM_WAIT(); SWRITE(bf ^ 1); }
        __syncthreads();
        { const LAS int* fl = (const LAS int*)(lds + FLAG_OFF) + bf * 8; int alls = 1;
#pragma unroll
          for (int w = 0; w < 8; ++w) alls &= fl[w];
          if (alls) break; }
    }
#undef SLOAD
#undef SWRITE
    if (hi == 0) li_l[r32] = l_reg;
    LDS_WAIT();
#pragma unroll
    for (int r = 0; r < 16; ++r) { const float rl = __builtin_amdgcn_rcpf(li_l[crow(r, hi)]);
#pragma unroll
        for (int d = 0; d < 4; ++d) o[d][r] *= rl; }
    LAS float* EX = (LAS float*)lds;
    if (s == 1) {
#pragma unroll
        for (int d = 0; d < 4; ++d)
#pragma unroll
            for (int r = 0; r < 16; ++r) EX[(((wid - 4) * 4 + d) * 16 + r) * 64 + lane] = o[d][r];
    }
    __syncthreads();
    LAS float* SSQ = (LAS float*)(lds + AUX_OFF);
    if (s == 0) {
#pragma unroll
        for (int d = 0; d < 4; ++d)
#pragma unroll
            for (int r = 0; r < 16; ++r) o[d][r] -= lam * EX[((wid * 4 + d) * 16 + r) * 64 + lane];
#pragma unroll
        for (int r = 0; r < 16; ++r) { float q = o[0][r] * o[0][r] + o[1][r] * o[1][r] + o[2][r] * o[2][r] + o[3][r] * o[3][r];
            q += __shfl_xor(q, 1); q += __shfl_xor(q, 2); q += __shfl_xor(q, 4); q += __shfl_xor(q, 8); q += __shfl_xor(q, 16);
            if (r32 == 0) SSQ[wid * 32 + crow(r, hi)] = q; }
    }
    __syncthreads();
    if (s == 0) {
        float gs[4];
#pragma unroll
        for (int d = 0; d < 4; ++d) gs[d] = gsub[v * 128 + d * 32 + r32] * 0.8f;
#pragma unroll
        for (int r = 0; r < 16; ++r) { const float tot = SSQ[wid * 32 + crow(r, hi)] + SSQ[(wid ^ 2) * 32 + crow(r, hi)];
            const float rstd = rsqrtf(tot * (1.f / 256.f) + EPS);
#pragma unroll
            for (int d = 0; d < 4; ++d) o[d][r] *= rstd * gs[d]; }
        store_o(o, MIX + (rowb + P0 + g * 32) * (size_t)D + 2048 + hd * 256 + v * 128, D, r32, hi);
    }
    __syncthreads();
}
#define ABAR() do { asm volatile("s_waitcnt lgkmcnt(0)" ::: "memory"); __builtin_amdgcn_s_barrier(); asm volatile("" ::: "memory"); } while (0)
template <int MODE>
__device__ __forceinline__ void std_unit_p(LAS char* lds, const StdArgs& A, int b, int qb) {
    const int tid = opaque_tid(), wid = __builtin_amdgcn_readfirstlane(tid >> 6), lane = tid & 63, r32 = lane & 31, hi = lane >> 5;
    const int ldsbase = (int)(unsigned)(size_t)lds;
    constexpr int K_OFF = 0, V_OFF = 32768, KR_OFF = 65536;
    LAS float* scr = (LAS float*)(lds + SCR_OFF) + wid * 64; LAS float* li_l = scr; LAS float* al_l = scr + 32;
    const int P0 = qb * 256; const size_t rowb = (size_t)b * S; const int tpos = P0 + wid * 32 + r32;
    const bool grpB = wid >= 4;
    const int cw = 4 * qb + (wid >> 1);
    int jstart, NT, jlo_w;
    if (MODE == MODE_MLA) { jstart = 0; NT = 4 * qb + 4; jlo_w = 0; }
    else { jstart = 4 * qb - 8 < 0 ? 0 : 4 * qb - 8; NT = 4 * qb + 4 - jstart; jlo_w = cw - 8; }
    constexpr int NQ = (MODE == MODE_MLA) ? 12 : 8;
    bf16x8 qr[NQ];
    { const bf16* qp = A.Q + (rowb + tpos) * (size_t)A.ldq + A.qcol + hi * 8;
#pragma unroll
      for (int d0 = 0; d0 < 8; ++d0) qr[d0] = *(const bf16x8*)(qp + d0 * 16);
      if constexpr (MODE == MODE_MLA) {
          v4u e[4];
#pragma unroll
          for (int k = 0; k < 4; ++k) e[k] = *(const v4u*)(qp + 128 + k * 16);
#pragma unroll
          for (int kk = 0; kk < 2; ++kk) { v4u o1, o2;
#pragma unroll
              for (int w = 0; w < 4; ++w) { const unsigned a = e[kk][w], c = e[kk + 2][w];
                  const int i0 = kk * 16 + hi * 8 + 2 * w;
                  const f32x4 cs = *(const f32x4*)(A.TAB + ((size_t)tpos * 32 + i0) * 2);
                  const float x1a = bflo(a), x1b = bfhi(a), x2a = bflo(c), x2b = bfhi(c);
                  o1[w] = cvtpk(x1a * cs[0] - x2a * cs[1], x1b * cs[2] - x2b * cs[3]);
                  o2[w] = cvtpk(x2a * cs[0] + x1a * cs[1], x2b * cs[2] + x1b * cs[3]); }
              qr[8 + kk] = __builtin_bit_cast(bf16x8, o1); qr[10 + kk] = __builtin_bit_cast(bf16x8, o2); }
      } }
    const int sr = tid >> 4, sc = (tid & 15) * 8;
    const int kws = KSWZ(sr, sc * 2), vst0 = v_st(sr, sc), vst1 = v_st(32 + sr, sc);
    const int rr_r = tid >> 3, rr_c = (tid & 7) * 8, krs = KSWZ64(rr_r, rr_c * 2);
    const bf16* Kg = A.K + rowb * (size_t)A.ldk + A.kcol + sc; const bf16* Vg = A.V + rowb * (size_t)A.ldv + A.vcol + sc;
    const bf16* KRg = A.KR + rowb * 64 + rr_c;
    bf16x8 st_k0, st_k1, st_v0, st_v1, st_r;
#define KLOAD(j) do { const size_t k0_ = (size_t)(j) * 64; st_k0 = *(const bf16x8*)(Kg + (k0_ + sr) * A.ldk); st_k1 = *(const bf16x8*)(Kg + (k0_ + 32 + sr) * A.ldk); \
        if constexpr (MODE == MODE_MLA) st_r = *(const bf16x8*)(KRg + (k0_ + rr_r) * 64); } while (0)
#define VLOAD(j) do { const size_t k0_ = (size_t)(j) * 64; st_v0 = *(const bf16x8*)(Vg + (k0_ + sr) * A.ldv); st_v1 = *(const bf16x8*)(Vg + (k0_ + 32 + sr) * A.ldv); } while (0)
#define KWRITE(bf) do { *(LAS bf16x8*)(lds + K_OFF + (bf) * SHM_T + kws) = st_k0; *(LAS bf16x8*)(lds + K_OFF + (bf) * SHM_T + kws + 32 * 256) = st_k1; \
        if constexpr (MODE == MODE_MLA) *(LAS bf16x8*)(lds + KR_OFF + (bf) * 8192 + krs) = st_r; } while (0)
#define VWRITE(bf) do { *(LAS bf16x8*)(lds + V_OFF + (bf) * SHM_T + vst0) = st_v0; *(LAS bf16x8*)(lds + V_OFF + (bf) * SHM_T + vst1) = st_v1; } while (0)
    if constexpr (MODE == MODE_CH) { LAS float* bt = (LAS float*)(lds + AUX_OFF); if (tid < 257) bt[tid] = A.bias[tid] * LOG2E; }
    float m_reg = -1e30f, l_reg = 0.f;
    f32x16 o[4];
#pragma unroll
    for (int d = 0; d < 4; ++d)
#pragma unroll
        for (int r = 0; r < 16; ++r) o[d][r] = 0.f;
    KLOAD(jstart); KWRITE(0);
    if (NT > 1) KLOAD(jstart + 1);
    VLOAD(jstart);
    ABAR();
    if (grpB) ABAR();
    f32x16 p0, p1; bf16x8 pa0, pa1, pa2, pa3;
    for (int i = 0; i <= NT; ++i) {
        const int j = jstart + i;
        if (i < NT) { if (i + 1 < NT) KWRITE((i + 1) & 1); VWRITE(i & 1); }
        if (i + 2 < NT) KLOAD(j + 2);
        if (i + 1 < NT) VLOAD(j + 1);
        const bool act_prev = i > 0 && (j - 1 >= jlo_w) && (j - 1 <= cw);
        const bool act_cur = i < NT && (j >= jlo_w) && (j <= cw);
        if (act_prev) pv_tile(o, ldsbase + V_OFF + ((i - 1) & 1) * SHM_T + v_rd_base(lane), pa0, pa1, pa2, pa3);
        if (act_cur) {
#pragma unroll
            for (int r = 0; r < 16; ++r) { p0[r] = 0.f; p1[r] = 0.f; }
            qkt128(p0, p1, ldsbase + K_OFF + (i & 1) * SHM_T, r32, hi, qr);
            if constexpr (MODE == MODE_MLA) qkt64(p0, p1, ldsbase + KR_OFF + (i & 1) * 8192, r32, hi, qr + 8);
#ifdef PROBE_DUP_QK
            asm volatile("" : "+v"(p0), "+v"(p1));
#pragma unroll
            for (int r = 0; r < 16; ++r) { p0[r] = 0.f; p1[r] = 0.f; }
            qkt128(p0, p1, ldsbase + K_OFF + (i & 1) * SHM_T, r32, hi, qr);
            if constexpr (MODE == MODE_MLA) qkt64(p0, p1, ldsbase + KR_OFF + (i & 1) * 8192, r32, hi, qr + 8);
#endif
        }
        ABAR();
        if (act_cur) {
            if constexpr (MODE == MODE_MLA) { const float C2 = 0.07216878364870322f * LOG2E;
#pragma unroll
                for (int r = 0; r < 16; ++r) { p0[r] *= C2; p1[r] *= C2; } }
            else { const float C2 = 0.08838834764831845f * LOG2E; const LAS float* bt = (const LAS float*)(lds + AUX_OFF);
                if (j <= cw - 3) { const float bc = bt[256];
#pragma unroll
                    for (int r = 0; r < 16; ++r) { p0[r] = p0[r] * C2 + bc; p1[r] = p1[r] * C2 + bc; } }
                else { const int dq = tpos - j * 64 - 4 * hi + 128;
#pragma unroll
                    for (int r = 0; r < 16; ++r) { const int c = (r & 3) + 8 * (r >> 2);
                        int i0 = dq - c, i1 = dq - c - 32; i0 = i0 < 0 ? 0 : (i0 > 256 ? 256 : i0); i1 = i1 < 0 ? 0 : (i1 > 256 ? 256 : i1);
                        p0[r] = p0[r] * C2 + bt[i0]; p1[r] = p1[r] * C2 + bt[i1]; } } }
            float alpha;
            osm(p0, p1, m_reg, l_reg, alpha, pa0, pa1, pa2, pa3);
            rescale_o(o, alpha, al_l, r32, hi);
        }
        ABAR();
    }
    if (!grpB) ABAR();
#undef KLOAD
#undef VLOAD
#undef KWRITE
#undef VWRITE
    {
      const int tid2 = opaque_tid(), wid2 = __builtin_amdgcn_readfirstlane(tid2 >> 6), lane2 = tid2 & 63, r32b = lane2 & 31, hib = lane2 >> 5;
      LAS float* li2 = (LAS float*)(lds + SCR_OFF) + wid2 * 64;
      if (hib == 0) li2[r32b] = l_reg;
      LDS_WAIT();
#pragma unroll
      for (int r = 0; r < 16; ++r) { const float rl = __builtin_amdgcn_rcpf(li2[crow(r, hib)]);
#pragma unroll
          for (int d = 0; d < 4; ++d) o[d][r] *= rl; }
      store_o(o, A.O + ((size_t)b * S + qb * 256 + wid2 * 32) * (size_t)D + A.ocol, D, r32b, hib); }
}
}
#define XB_TMO      128
#define XB_XCNT(j)  (256  + 64 * (j))
#define XB_XSUB(j)  (1280 + 64 * (j))
#define XB_XGEN(j)  (2304 + 64 * (j))
#define XB_TOP      3328
#define XB_TOPGEN   3392
#define XCD_BAR_WORDS 3456
#define XB_SPIN_CAP (1u << 18)

__device__ __forceinline__ unsigned xb_ld(unsigned* p)              { return __hip_atomic_load(p, __ATOMIC_RELAXED, __HIP_MEMORY_SCOPE_AGENT); }
__device__ __forceinline__ unsigned xb_add(unsigned* p, unsigned v) { return __hip_atomic_fetch_add(p, v, __ATOMIC_RELAXED, __HIP_MEMORY_SCOPE_AGENT); }
__device__ __forceinline__ unsigned xb_xcc_id() { return (unsigned)__builtin_amdgcn_s_getreg((3 << 11) | 20) & 0xFu; }
#define XB_SPIN(cond, bar) do { unsigned _sp = 0; while (cond) { __builtin_amdgcn_s_sleep(1); \
    if ((++_sp & 255u) == 0u) { if (xb_ld(&(bar)[XB_TMO])) break; if (_sp > XB_SPIN_CAP) { atomicAdd(&(bar)[XB_TMO], 1u); break; } } } } while (0)

struct XcdBarrier {
    unsigned* bar; unsigned x;
    volatile LAS unsigned* st;
};

__device__ __forceinline__ XcdBarrier xcd_barrier_post(unsigned* bar, volatile LAS unsigned* st) {
    XcdBarrier b; b.bar = bar; b.x = xb_xcc_id(); b.st = st;
    if (threadIdx.x == 0) (void)xb_add(&bar[XB_XCNT(b.x)], 1u);
    return b;
}
__device__ __forceinline__ void xcd_barrier_complete(unsigned* bar, unsigned x, unsigned& nloc, unsigned& nx) {
    const unsigned G = gridDim.x * gridDim.y * gridDim.z;
    unsigned sum, cnt, mine, sp = 0u;
    for (;;) {
        sum = 0u; cnt = 0u; mine = 0u;
#pragma unroll
        for (unsigned j = 0; j < 16; ++j) { const unsigned c = xb_ld(&bar[XB_XCNT(j)]); sum += c; cnt += (c > 0u) ? 1u : 0u; mine = (j == x) ? c : mine; }
        if (sum == G) break;
        __builtin_amdgcn_s_sleep(1);
        if ((++sp & 255u) == 0u) { if (xb_ld(&bar[XB_TMO])) break; if (sp > XB_SPIN_CAP) { atomicAdd(&bar[XB_TMO], 1u); break; } }
    }
    nloc = mine > 0u ? mine : 1u; nx = cnt > 0u ? cnt : 1u;
}

__device__ __forceinline__ void xcd_barrier(const XcdBarrier& b) {
    asm volatile("s_waitcnt vmcnt(0)" ::: "memory");
    __syncthreads();
    if (threadIdx.x == 0) {
        unsigned* bar = b.bar;
        __builtin_amdgcn_s_waitcnt(0);
        unsigned nloc = b.st[0], nx = b.st[1];
        if (nloc == 0u) { xcd_barrier_complete(bar, b.x, nloc, nx); b.st[0] = nloc; b.st[1] = nx; }
        const unsigned old = xb_add(&bar[XB_XSUB(b.x)], 1u);
        const unsigned gen = old / nloc;
        if (old + 1u == (gen + 1u) * nloc) {
            __builtin_amdgcn_fence(__ATOMIC_RELEASE, "agent");
            asm volatile("s_waitcnt vmcnt(0)" ::: "memory");
            const unsigned og = xb_add(&bar[XB_TOP], 1u);
            const unsigned tg = og / nx;
            if (og + 1u == (tg + 1u) * nx) xb_add(&bar[XB_TOPGEN], 1u);
            else XB_SPIN(xb_ld(&bar[XB_TOPGEN]) == tg, bar);
            __builtin_amdgcn_fence(__ATOMIC_ACQUIRE, "agent");
            xb_add(&bar[XB_XGEN(b.x)], 1u);
            asm volatile("s_waitcnt vmcnt(0)" ::: "memory");
        } else {
            XB_SPIN(xb_ld(&bar[XB_XGEN(b.x)]) == gen, bar);
            __builtin_amdgcn_fence(__ATOMIC_ACQUIRE, "agent");
            asm volatile("s_waitcnt vmcnt(0)" ::: "memory");
        }
    }
    __syncthreads();
}

constexpr size_t MiB = (size_t)1 << 20;
constexpr size_t WS_CTL = 0, CTL_ZERO_BYTES = 1 * MiB;
constexpr size_t WS_TAB = 1 * MiB;
constexpr size_t WS_WIN0 = 2 * MiB;
constexpr size_t WS_WOUT0 = 98 * MiB;
constexpr size_t WS_WIN1 = 130 * MiB;
constexpr size_t WS_WOUT1 = 192 * MiB;
constexpr size_t WS_WUQ = 224 * MiB;
constexpr size_t WS_WUKV = 230 * MiB;
constexpr int LDW = D + 64;
constexpr size_t WS_WFI = 1916 * MiB;
constexpr size_t WS_WFO = 578 * MiB;
constexpr size_t WS_XB = 750 * MiB;
constexpr size_t WS_RS = 814 * MiB;
constexpr size_t WS_QKV = 942 * MiB;
constexpr size_t WS_MIX = 1134 * MiB;
constexpr size_t WS_MO = 1198 * MiB;
constexpr size_t WS_HALO = 1262 * MiB;
constexpr size_t WS_G = 1606 * MiB;
constexpr size_t WS_CQN = 1778 * MiB;
constexpr size_t WS_CKVN = 1794 * MiB;
constexpr size_t WS_KROPE = 1802 * MiB;
constexpr size_t WS_QUP = 1804 * MiB;
constexpr size_t WS_KVUP = 1852 * MiB;
constexpr size_t WS_END = 2268 * MiB;
constexpr int CW_BAR = 4096;
constexpr int CW_KM = 8192;
constexpr int CW_Q = 8448;

__constant__ float INV_FREQ[32] = {1.0f, 0.7498942613601685f, 0.5623413324356079f, 0.4216965138912201f, 0.3162277638912201f, 0.23713737726211548f, 0.17782793939113617f, 0.133352130651474f,
    0.10000000149011612f, 0.07498941570520401f, 0.05623413249850273f, 0.04216965287923813f, 0.03162277489900589f, 0.023713737726211548f, 0.017782794311642647f, 0.01333521492779255f,
    0.009999999776482582f, 0.007498941849917173f, 0.005623413249850273f, 0.0042169648222625256f, 0.003162277629598975f, 0.00237137358635664f, 0.0017782794311642647f, 0.0013335214462131262f,
    0.0010000000474974513f, 0.0007498942431993783f, 0.000562341301701963f, 0.0004216965171508491f, 0.0003162277571391314f, 0.00023713737027719617f, 0.00017782794020604342f, 0.0001333521504420787f};

__device__ __forceinline__ void tr_item(const float* __restrict__ W, int K, int N, bf16* WT, const float* gain  , bool ffperm  , LAS float* scr, int item, int lane) {
    const int nblk = N / 64, kb = item / nblk, nb = item - kb * nblk, k0 = 64 * kb, n0 = 64 * nb;
    const int r4 = lane >> 4, c4 = (lane & 15) * 4;
    const float* src = W + (size_t)(k0 + r4) * N + n0 + c4;
    f32x4 v[16];
#pragma unroll
    for (int i = 0; i < 16; ++i) v[i] = *(const f32x4*)(src + (size_t)(4 * i) * N);
    if (gain) {
#pragma unroll
        for (int i = 0; i < 16; ++i) v[i] *= gain[k0 + 4 * i + r4];
    }
#pragma unroll
    for (int i = 0; i < 16; ++i) { LAS float* d = scr + (4 * i + r4) * 65 + c4; d[0] = v[i][0]; d[1] = v[i][1]; d[2] = v[i][2]; d[3] = v[i][3]; }
    LDS_WAIT(); asm volatile("" ::: "memory");
    const int c = lane & 7;
#pragma unroll
    for (int j = 0; j < 8; ++j) { const int n = (lane >> 3) + 8 * j; const LAS float* s = scr + (8 * c) * 65 + n;
        v4u o; o.x = cvtpk(s[0], s[65]); o.y = cvtpk(s[130], s[195]); o.z = cvtpk(s[260], s[325]); o.w = cvtpk(s[390], s[455]);
        int nd = n0 + n; if (ffperm) { const int hf = nd >= FF ? 1 : 0, nn = nd - hf * FF; nd = (nn >> 7) * 256 + hf * 128 + (nn & 127); }
        *(v4u*)(WT + ((size_t)((nd >> 8) * (K >> 6) + kb) * 256 + (nd & 255)) * 64 + 8 * c) = o; }
    LDS_WAIT(); asm volatile("" ::: "memory");
}
__device__ __forceinline__ void rms_row_bf16(const float* xrow, bf16* orow, float* rs, int lane) {
    f32x4 v[16]; float ss = 0.f;
#pragma unroll
    for (int j = 0; j < 16; ++j) { v[j] = ((const f32x4*)xrow)[lane + 64 * j]; ss += (v[j][0] * v[j][0] + v[j][1] * v[j][1]) + (v[j][2] * v[j][2] + v[j][3] * v[j][3]); }
    const float rstd = rsqrtf(wave_sum(ss) * (1.f / D) + EPS);
    if (lane == 0) *rs = rstd;
#pragma unroll
    for (int j = 0; j < 16; ++j) { v2u w; w.x = cvtpk(v[j][0], v[j][1]); w.y = cvtpk(v[j][2], v[j][3]); ((v2u*)orow)[lane + 64 * j] = w; }
}

struct Ptrs {
    const float *x, *norm_g, *even_w_in, *even_w_out, *diff_lambda, *diff_subln_g, *odd_w_in, *odd_w_out, *ch_rel_bias, *mla_q_norm_g, *mla_w_uq, *mla_kv_norm_g, *mla_w_ukv,
                *ffn_w_in, *ffn_conv_w, *ffn_conv_b, *ffn_w_out;
    float* out; unsigned char* ws;
};

__device__ __forceinline__ void p_prologue(const Ptrs& P, LAS unsigned char* lds, int G) {
    const int tid = opaque_tid(), lane = tid & 63, wave = __builtin_amdgcn_readfirstlane(tid >> 6);
    LAS float* scr = (LAS float*)(lds + wave * 16640);
    const int gw = blockIdx.x * NWAVES + wave, NGW = G * NWAVES;
    unsigned char* ws = P.ws;
    constexpr int I_IN0 = 64 * 192, I_OUT = 64 * 64, I_IN1 = 64 * 121, I_UQ = 16 * 48, I_UKV = 8 * 64, I_FI = 64 * 344, I_FO = 172 * 64;
    constexpr int NITEMS = I_IN0 + 2 * I_OUT + I_IN1 + I_UQ + I_UKV + 2 * I_FI + 2 * I_FO;
    for (int it = gw; it < NITEMS; it += NGW) {
        int r = it; const float* W; bf16* WT; int K, N; const float* gn = nullptr;
        if (r < I_FI) { W = P.ffn_w_in; WT = (bf16*)(ws + WS_WFI); K = D; N = FF2; gn = P.norm_g + 2 * D; }
        else if ((r -= I_FI) < I_FI) { W = P.ffn_w_in + (size_t)D * FF2; WT = (bf16*)(ws + WS_WFI) + (size_t)FF2 * D; K = D; N = FF2; gn = P.norm_g + 6 * D; }
        else if ((r -= I_FI) < I_FO) { W = P.ffn_w_out; WT = (bf16*)(ws + WS_WFO); K = FF; N = D; }
        else if ((r -= I_FO) < I_FO) { W = P.ffn_w_out + (size_t)FF * D; WT = (bf16*)(ws + WS_WFO) + (size_t)D * FF; K = FF; N = D; }
        else if ((r -= I_FO) < I_IN0) { W = P.even_w_in; WT = (bf16*)(ws + WS_WIN0); K = D; N = EVEN_IN; gn = P.norm_g; }
        else if ((r -= I_IN0) < I_OUT) { W = P.even_w_out; WT = (bf16*)(ws + WS_WOUT0); K = D; N = D; }
        else if ((r -= I_OUT) < I_IN1) { W = P.odd_w_in; WT = (bf16*)(ws + WS_WIN1); K = D; N = ODD_IN; gn = P.norm_g + 4 * D; }
        else if ((r -= I_IN1) < I_OUT) { W = P.odd_w_out; WT = (bf16*)(ws + WS_WOUT1); K = D; N = D; }
        else if ((r -= I_OUT) < I_UQ) { W = P.mla_w_uq; WT = (bf16*)(ws + WS_WUQ); K = QLORA; N = QUP_N; }
        else { r -= I_UQ; W = P.mla_w_ukv; WT = (bf16*)(ws + WS_WUKV); K = KVLORA; N = KVUP_N; }
        tr_item(W, K, N, WT, gn, N == FF2, scr, r, lane);
    }
    { bf16* wb = (bf16*)(ws + WS_WIN1); constexpr int PER = (ODD_IN_P - ODD_IN) * 64 * 2 / 16, n16 = (D / 64) * PER;
      for (int i = blockIdx.x * 512 + tid; i < n16; i += G * 512) { const int kt = i / PER, j = i - kt * PER;
          ((v4u*)(wb + ((size_t)((ODD_IN >> 8) * (D / 64) + kt) * 256 + (ODD_IN & 255)) * 64))[j] = (v4u){0u, 0u, 0u, 0u}; } }
    { float* tab = (float*)(ws + WS_TAB);
      for (int i = blockIdx.x * 512 + tid; i < S * 32; i += G * 512) { const int pos = i >> 5, f = i & 31;
          const float ang = (float)pos * INV_FREQ[f];
          double rv = (double)ang * 0.15915494309189535; rv -= __builtin_rint(rv); const float fr = (float)rv;
          tab[2 * i] = __builtin_amdgcn_cosf(fr); tab[2 * i + 1] = __builtin_amdgcn_sinf(fr); } }
    for (int m = gw; m < M; m += NGW) rms_row_bf16(P.x + (size_t)m * D, (bf16*)(ws + WS_XB) + (size_t)m * D, (float*)(ws + WS_RS) + m, lane);
}

template <int MODE>
__device__ __forceinline__ void p_rowpass(const bf16* MO, const float* xf, bf16* XB, float* RS, const float* gpost, float* outf, int G) {
    const int tid = opaque_tid(), lane_ = tid & 63, wave = __builtin_amdgcn_readfirstlane(tid >> 6);
    const int gw = blockIdx.x * NWAVES + wave, NGW = G * NWAVES;
    for (int row = gw; row < M; row += NGW) {
        int lane = lane_; asm volatile("" : "+v"(lane));
        const v4u* mo = (const v4u*)(MO + (size_t)row * D);
        float mv[8][8]; float ss = 0.f;
#pragma unroll
        for (int j = 0; j < 8; ++j) { const v4u w = mo[lane + 64 * j];
#pragma unroll
            for (int k = 0; k < 4; ++k) { mv[j][2 * k] = bflo(w[k]); mv[j][2 * k + 1] = bfhi(w[k]); ss += mv[j][2 * k] * mv[j][2 * k] + mv[j][2 * k + 1] * mv[j][2 * k + 1]; } }
        const float rstd = rsqrtf(wave_sum(ss) * (1.f / D) + EPS);
        float ss2 = 0.f;
#pragma unroll
        for (int j = 0; j < 8; ++j) { const int e = 2 * (lane + 64 * j);
            float xv[8];
            if constexpr (MODE == 0) { const f32x4 a = ((const f32x4*)(xf + (size_t)row * D))[e], c = ((const f32x4*)(xf + (size_t)row * D))[e + 1];
#pragma unroll
                for (int k = 0; k < 4; ++k) { xv[k] = a[k]; xv[4 + k] = c[k]; } }
            else { const v4u w = ((const v4u*)(XB + (size_t)row * D))[lane + 64 * j];
#pragma unroll
                for (int k = 0; k < 4; ++k) { xv[2 * k] = bflo(w[k]); xv[2 * k + 1] = bfhi(w[k]); } }
            const f32x4 g0 = ((const f32x4*)gpost)[e], g1 = ((const f32x4*)gpost)[e + 1];
#pragma unroll
            for (int k = 0; k < 4; ++k) { xv[k] += mv[j][k] * rstd * g0[k]; xv[4 + k] += mv[j][4 + k] * rstd * g1[k]; }
#pragma unroll
            for (int k = 0; k < 8; ++k) ss2 += xv[k] * xv[k];
            if constexpr (MODE == 2) { ((f32x4*)(outf + (size_t)row * D))[e] = (f32x4){xv[0], xv[1], xv[2], xv[3]}; ((f32x4*)(outf + (size_t)row * D))[e + 1] = (f32x4){xv[4], xv[5], xv[6], xv[7]}; }
            else { v4u w; w.x = cvtpk(xv[0], xv[1]); w.y = cvtpk(xv[2], xv[3]); w.z = cvtpk(xv[4], xv[5]); w.w = cvtpk(xv[6], xv[7]); ((v4u*)(XB + (size_t)row * D))[lane + 64 * j] = w; }
            if (j & 1) asm volatile("" ::: "memory"); }
        if constexpr (MODE != 2) { const float rstd2 = rsqrtf(wave_sum(ss2) * (1.f / D) + EPS); if (lane == 0) RS[row] = rstd2; }
    }
}

__device__ __forceinline__ float gelu_tanh(float x) {
    const float u = x * (1.f + 0.044715f * x * x);
    const float e = __builtin_amdgcn_exp2f(-2.f * 0.7978845608028654f * LOG2E * u);
    return x * __builtin_amdgcn_rcpf(1.f + e);
}
__device__ __forceinline__ void unpack8(const v4u w, float* f) {
#pragma unroll
    for (int k = 0; k < 4; ++k) { f[2 * k] = bflo(w[k]); f[2 * k + 1] = bfhi(w[k]); }
}
__device__ __forceinline__ void p_conv(const bf16* U, const float* rs  , const float* cw, const float* cb, bf16* Gm, int G) {
    constexpr int NCG = FF / 8, RUN = 32, NRUN = M / RUN;
    const int gtid = blockIdx.x * 512 + opaque_tid(), nthr = G * 512;
    for (int task = gtid; task < NCG * NRUN; task += nthr) {
        const int cg = task % NCG, run = task / NCG, c0 = cg * 8, r0 = run * RUN;
        float wg[3][8], wv[3][8], bg[8], bv[8];
#pragma unroll
        for (int j = 0; j < 3; ++j)
#pragma unroll
            for (int h = 0; h < 2; ++h) { const f32x4 a = *(const f32x4*)(cw + (size_t)j * FF2 + c0 + 4 * h), b = *(const f32x4*)(cw + (size_t)j * FF2 + FF + c0 + 4 * h);
#pragma unroll
                for (int k = 0; k < 4; ++k) { wg[j][4 * h + k] = a[k]; wv[j][4 * h + k] = b[k]; } }
#pragma unroll
        for (int h = 0; h < 2; ++h) { const f32x4 a = *(const f32x4*)(cb + c0 + 4 * h), b = *(const f32x4*)(cb + FF + c0 + 4 * h);
#pragma unroll
            for (int k = 0; k < 4; ++k) { bg[4 * h + k] = a[k]; bv[4 * h + k] = b[k]; } }
        float g1[8], g2[8], v1[8], v2[8];
        if ((r0 % S) == 0) {
#pragma unroll
            for (int k = 0; k < 8; ++k) { g1[k] = 0.f; g2[k] = 0.f; v1[k] = 0.f; v2[k] = 0.f; }
        } else {
            const bf16* u1 = U + (size_t)(r0 - 1) * FF2 + c0; const bf16* u2 = U + (size_t)(r0 - 2) * FF2 + c0;
            unpack8(*(const v4u*)u1, g1); unpack8(*(const v4u*)(u1 + FF), v1); unpack8(*(const v4u*)u2, g2); unpack8(*(const v4u*)(u2 + FF), v2);
            const float s1 = rs[r0 - 1], s2 = rs[r0 - 2];
#pragma unroll
            for (int k = 0; k < 8; ++k) { g1[k] *= s1; v1[k] *= s1; g2[k] *= s2; v2[k] *= s2; }
        }
#pragma unroll 4
        for (int rr = 0; rr < RUN; ++rr) {
            const bf16* u0 = U + (size_t)(r0 + rr) * FF2 + c0;
            float g0[8], v0[8]; unpack8(*(const v4u*)u0, g0); unpack8(*(const v4u*)(u0 + FF), v0);
            { const float s0 = rs[r0 + rr];
#pragma unroll
              for (int k = 0; k < 8; ++k) { g0[k] *= s0; v0[k] *= s0; } }
            float o[8];
#pragma unroll
            for (int k = 0; k < 8; ++k) { const float yg = bg[k] + wg[0][k] * g2[k] + wg[1][k] * g1[k] + wg[2][k] * g0[k];
                const float yv = bv[k] + wv[0][k] * v2[k] + wv[1][k] * v1[k] + wv[2][k] * v0[k];
                o[k] = gelu_tanh(yg) * yv; g2[k] = g1[k]; g1[k] = g0[k]; v2[k] = v1[k]; v1[k] = v0[k]; }
            v4u w; w.x = cvtpk(o[0], o[1]); w.y = cvtpk(o[2], o[3]); w.z = cvtpk(o[4], o[5]); w.w = cvtpk(o[6], o[7]);
            *(v4u*)(Gm + (size_t)(r0 + rr) * FF + c0) = w;
        }
    }
}

__device__ __forceinline__ void p_mlaprep(const bf16* QKV, const float* gq, const float* gkv, const float* tab, bf16* CQN, bf16* CKVN, bf16* KROPE, int G) {
    const int tid = opaque_tid(), lane = tid & 63, wave = __builtin_amdgcn_readfirstlane(tid >> 6);
    const int gw = blockIdx.x * NWAVES + wave, NGW = G * NWAVES;
    for (int row = gw; row < M; row += NGW) {
        const bf16* base = QKV + (size_t)row * ODD_IN_P;
        { float f[2][8]; float ss = 0.f;
#pragma unroll
          for (int j = 0; j < 2; ++j) { unpack8(((const v4u*)(base + 6144))[lane + 64 * j], f[j]);
#pragma unroll
              for (int k = 0; k < 8; ++k) ss += f[j][k] * f[j][k]; }
          const float rstd = rsqrtf(wave_sum(ss) * (1.f / QLORA) + EPS);
#pragma unroll
          for (int j = 0; j < 2; ++j) { const int e = 2 * (lane + 64 * j); const f32x4 g0 = ((const f32x4*)gq)[e], g1 = ((const f32x4*)gq)[e + 1];
              v4u w; w.x = cvtpk(f[j][0] * rstd * g0[0], f[j][1] * rstd * g0[1]); w.y = cvtpk(f[j][2] * rstd * g0[2], f[j][3] * rstd * g0[3]);
              w.z = cvtpk(f[j][4] * rstd * g1[0], f[j][5] * rstd * g1[1]); w.w = cvtpk(f[j][6] * rstd * g1[2], f[j][7] * rstd * g1[3]);
              ((v4u*)(CQN + (size_t)row * QLORA))[lane + 64 * j] = w; } }
        { float f[8]; float ss = 0.f; unpack8(((const v4u*)(base + 7168))[lane], f);
#pragma unroll
          for (int k = 0; k < 8; ++k) ss += f[k] * f[k];
          const float rstd = rsqrtf(wave_sum(ss) * (1.f / KVLORA) + EPS);
          const int e = 2 * lane; const f32x4 g0 = ((const f32x4*)gkv)[e], g1 = ((const f32x4*)gkv)[e + 1];
          v4u w; w.x = cvtpk(f[0] * rstd * g0[0], f[1] * rstd * g0[1]); w.y = cvtpk(f[2] * rstd * g0[2], f[3] * rstd * g0[3]);
          w.z = cvtpk(f[4] * rstd * g1[0], f[5] * rstd * g1[1]); w.w = cvtpk(f[6] * rstd * g1[2], f[7] * rstd * g1[3]);
          ((v4u*)(CKVN + (size_t)row * KVLORA))[lane] = w; }
        if (lane < 32) { const int pos = row % S; const float x1 = __uint_as_float((unsigned)base[7680 + lane] << 16), x2 = __uint_as_float((unsigned)base[7712 + lane] << 16);
            const float cs = tab[((size_t)pos * 32 + lane) * 2], sn = tab[((size_t)pos * 32 + lane) * 2 + 1];
            const unsigned a = cvtpk(x1 * cs - x2 * sn, 0.f), c = cvtpk(x2 * cs + x1 * sn, 0.f);
            KROPE[(size_t)row * 64 + lane] = (bf16)(a & 0xffffu); KROPE[(size_t)row * 64 + 32 + lane] = (bf16)(c & 0xffffu); }
    }
}


__device__ __forceinline__ void ffn_fixup(const float* halo, const float* cw, const float* cb, bf16* Gm, int pm) {
    const int tid = opaque_tid();
    const float* hF = halo + (size_t)(pm * 4) * FF2; const float* hL = halo + (size_t)((pm - 1) * 4 + 2) * FF2;
    for (int q = tid; q < FF / 4; q += NWAVES * 64) { const int c = 4 * q;
        v2u w0_, w1_;
        f32x4 y0[2], y1[2];
#pragma unroll
        for (int h = 0; h < 2; ++h) { const int cc = c + h * FF;
            const f32x4 u0 = *(const f32x4*)(hF + cc), u1 = *(const f32x4*)(hF + FF2 + cc), m2 = *(const f32x4*)(hL + cc), m1 = *(const f32x4*)(hL + FF2 + cc);
            const f32x4 k0 = *(const f32x4*)(cw + cc), k1 = *(const f32x4*)(cw + FF2 + cc), k2 = *(const f32x4*)(cw + 2 * FF2 + cc), bb = *(const f32x4*)(cb + cc);
            y0[h] = bb + k0 * m2 + k1 * m1 + k2 * u0; y1[h] = bb + k0 * m1 + k1 * u0 + k2 * u1; }
        float o0[4], o1[4];
#pragma unroll
        for (int k = 0; k < 4; ++k) { o0[k] = gelu_tanh(y0[0][k]) * y0[1][k]; o1[k] = gelu_tanh(y1[0][k]) * y1[1][k]; }
        w0_.x = cvtpk(o0[0], o0[1]); w0_.y = cvtpk(o0[2], o0[3]); w1_.x = cvtpk(o1[0], o1[1]); w1_.y = cvtpk(o1[2], o1[3]);
        *(v2u*)(Gm + (size_t)(pm * 256) * FF + c) = w0_; *(v2u*)(Gm + (size_t)(pm * 256 + 1) * FF + c) = w1_; }
}
__device__ __forceinline__ int xcd_item(int L, int N) { return (L & 7) * (N >> 3) + (L >> 3); }
__device__ __forceinline__ void p_attn_even(const Ptrs& P, LAS unsigned char* lds8, int G) {
    LAS char* lds = (LAS char*)lds8;
    const bf16* QKV = (const bf16*)(P.ws + WS_QKV); bf16* MIX = (bf16*)(P.ws + WS_MIX);
    const int lane = opaque_tid() & 63;
    float lam;
    { const float* dl = P.diff_lambda; const float a = dl[lane] * dl[128 + lane] + dl[64 + lane] * dl[192 + lane], c = dl[256 + lane] * dl[384 + lane] + dl[320 + lane] * dl[448 + lane];
      lam = __expf(wave_sum(a)) - __expf(wave_sum(c)) + 0.2f; }
    { const unsigned* km = (const unsigned*)(P.ws + WS_CTL) + CW_KM; unsigned* qh = (unsigned*)(P.ws + WS_CTL) + CW_Q; LAS int* qs = (LAS int*)(lds + FLAG_OFF + 64);
      for (;;) {
          if (threadIdx.x == 0) qs[0] = (int)__hip_atomic_fetch_add(qh, 1u, __ATOMIC_RELAXED, __HIP_MEMORY_SCOPE_AGENT);
          __syncthreads();
          const int u = qs[0];
          __syncthreads();
          if (u >= 1536) break;
          if (u < 1024) { const int c = 63 - (u >> 4), grp = u & 15, b = grp >> 3, hd = grp & 7;
              att::diff_unit(lds, QKV, P.diff_subln_g, km, lam, MIX, b, hd, c); }
          else { const int it = u - 1024, qb = 15 - (it >> 5), grp = it & 31, b = grp >> 4, h = grp & 15;
              att::StdArgs A; A.Q = QKV; A.ldq = EVEN_IN; A.qcol = h * 128; A.K = QKV; A.ldk = EVEN_IN; A.kcol = 2048 + h * 128; A.V = QKV; A.ldv = EVEN_IN; A.vcol = 4096 + h * 128;
              A.KR = nullptr; A.TAB = nullptr; A.bias = nullptr; A.O = MIX; A.ocol = h * 128;
              att::std_unit<att::MODE_SB>(lds, A, b, qb); }
      } }
}
__device__ __forceinline__ void p_attn_odd(const Ptrs& P, LAS unsigned char* lds8, int G) {
    LAS char* lds = (LAS char*)lds8;
    const bf16* QKV = (const bf16*)(P.ws + WS_QKV); bf16* MIX = (bf16*)(P.ws + WS_MIX);
    { unsigned* qh = (unsigned*)(P.ws + WS_CTL) + CW_Q + 64; LAS int* qs = (LAS int*)(lds + FLAG_OFF + 64);
      for (;;) {
          if (threadIdx.x == 0) qs[0] = (int)__hip_atomic_fetch_add(qh, 1u, __ATOMIC_RELAXED, __HIP_MEMORY_SCOPE_AGENT);
          __syncthreads();
          const int u = qs[0];
          __syncthreads();
          if (u >= 768) break;
          if (u < 256) { const int it = xcd_item(u, 256), grp = it >> 3, pr = it & 7, b = grp >> 4, h = grp & 15;
              att::StdArgs A; A.Q = (const bf16*)(P.ws + WS_QUP); A.ldq = QUP_N; A.qcol = h * 192; A.K = (const bf16*)(P.ws + WS_KVUP); A.ldk = KVUP_N; A.kcol = h * 256;
              A.V = A.K; A.ldv = KVUP_N; A.vcol = h * 256 + 128; A.KR = (const bf16*)(P.ws + WS_KROPE); A.TAB = (const float*)(P.ws + WS_TAB); A.bias = nullptr; A.O = MIX; A.ocol = 2048 + h * 128;
              att::std_unit_p<att::MODE_MLA>(lds, A, b, 15 - pr);
              att::std_unit_p<att::MODE_MLA>(lds, A, b, pr); }
          else { const int it = u - 256, qb = 15 - (it >> 5), grp = it & 31, b = grp >> 4, h = grp & 15;
              att::StdArgs A; A.Q = QKV; A.ldq = ODD_IN_P; A.qcol = h * 128; A.K = QKV; A.ldk = ODD_IN_P; A.kcol = 2048 + h * 128; A.V = QKV; A.ldv = ODD_IN_P; A.vcol = 4096 + h * 128;
              A.KR = nullptr; A.TAB = nullptr; A.bias = P.ch_rel_bias + h * 257; A.O = MIX; A.ocol = h * 128;
              att::std_unit_p<att::MODE_CH>(lds, A, b, qb); }
      } }
}

#ifdef PROBE_NULL_EPI
#define EPI_SKIP (rep_ > 0)
#else
#define EPI_SKIP 0
#endif
#ifndef GEMM_ALIGN
#define GEMM_ALIGN false
#endif
#ifndef GEMM_SP2
#define GEMM_SP2 true
#endif
struct Args { Ptrs p; int ph_lo, ph_hi; };
constexpr int N_PHASES = 21;

__global__ void __launch_bounds__(NWAVES * 64, 2) fwd(Args args) {
    extern __shared__ __attribute__((aligned(16))) unsigned char lds_raw[];
    LAS unsigned char* lds = (LAS unsigned char*)lds_raw;
    const Ptrs& P = args.p;
    const int tid = opaque_tid(), G = gridDim.x;
    unsigned char* ws = P.ws;
    for (int u = tid; u < (LDS_BYTES - LDSCTL_OFF) / 4; u += NWAVES * 64) ((LAS unsigned*)(lds + LDSCTL_OFF))[u] = 0u;
    __syncthreads();
    const int lo = args.ph_lo, hi = args.ph_hi;
    const bool fused = (hi - lo) > 1;
    XcdBarrier bar; bar.bar = (unsigned*)(ws + WS_CTL) + CW_BAR; bar.x = 0; bar.st = nullptr;
    if (fused) bar = xcd_barrier_post((unsigned*)(ws + WS_CTL) + CW_BAR, (volatile LAS unsigned*)(lds + MISC_OFF));
#ifndef KMASK
#define KMASK 0xfff
#endif
#define KIND(k) (((KMASK) >> (k)) & 1)
#ifndef KREP
#define KREP 0
#endif
#define REPS(k) for (int rep_ = 0; rep_ <= (((KREP) >> (k)) & 1); ++rep_)
#define IN(k) (lo <= (k) && (k) < hi)
#ifdef PROBE_DOUBLE_BAR
#define SEAM(k) do { if (IN(k) && IN((k) + 1)) { xcd_barrier(bar); xcd_barrier(bar); } } while (0)
#else
#define SEAM(k) do { if (IN(k) && IN((k) + 1)) xcd_barrier(bar); } while (0)
#endif

    if (KIND(0) && IN(0)) { REPS(0)  p_prologue(P, lds, G); SEAM(0); }

    for (int L = 0; L < 2; ++L) {
        const int pb = 1 + 10 * L;
        const float* ng = P.norm_g + (size_t)L * 4 * D;
        bf16* XB = (bf16*)(ws + WS_XB); float* RS = (float*)(ws + WS_RS); bf16* QKV = (bf16*)(ws + WS_QKV); bf16* MIX = (bf16*)(ws + WS_MIX); bf16* MO = (bf16*)(ws + WS_MO);
        if (KIND(1) && IN(pb + 0)) { REPS(1) {
            const int N = L ? ODD_IN_P : EVEN_IN;
            pg8::Gemm g{XB, (const bf16*)(ws + (L ? WS_WIN1 : WS_WIN0)), M, N, D, D, 64, 32768u, 512u * D}; pg8::StaticOrder So; So.init(M, N, G, (int)blockIdx.x);
            pg8::EpiStore E{QKV, N, EPI_SKIP, L ? nullptr : (unsigned*)(ws + WS_CTL) + CW_KM, RS};
            pg8::gemm_phase<pg8::EpiStore, pg8::StaticOrder, GEMM_ALIGN, GEMM_SP2>(lds + RING_OFF, g, So, E);
            } SEAM(pb + 0);
        }
        if (L == 0) {
            if (KIND(2) && IN(pb + 1)) { REPS(2)  p_attn_even(P, lds, G); if (IN(pb + 4)) xcd_barrier(bar); }
        } else {
            if (KIND(3) && IN(pb + 1)) { REPS(3)  p_mlaprep(QKV, P.mla_q_norm_g, P.mla_kv_norm_g, (const float*)(ws + WS_TAB), (bf16*)(ws + WS_CQN), (bf16*)(ws + WS_CKVN), (bf16*)(ws + WS_KROPE), G); SEAM(pb + 1); }
            if (KIND(4) && IN(pb + 2)) { REPS(4) {
                { pg8::Gemm g{(const bf16*)(ws + WS_CQN), (const bf16*)(ws + WS_WUQ), M, QUP_N, QLORA, QLORA, 64, 32768u, 512u * QLORA}; pg8::StaticOrder So; So.init(M, QUP_N, G, (int)blockIdx.x);
                  pg8::EpiStore E{(bf16*)(ws + WS_QUP), QUP_N, EPI_SKIP, nullptr, nullptr};
                  pg8::gemm_phase<pg8::EpiStore, pg8::StaticOrder, GEMM_ALIGN, GEMM_SP2>(lds + RING_OFF, g, So, E); }
                { pg8::Gemm g{(const bf16*)(ws + WS_CKVN), (const bf16*)(ws + WS_WUKV), M, KVUP_N, KVLORA, KVLORA, 64, 32768u, 512u * KVLORA}; pg8::StaticOrder So; So.init(M, KVUP_N, G, (int)blockIdx.x);
                  pg8::EpiStore E{(bf16*)(ws + WS_KVUP), KVUP_N, EPI_SKIP, nullptr, nullptr};
                  pg8::gemm_phase<pg8::EpiStore, pg8::StaticOrder, GEMM_ALIGN, GEMM_SP2>(lds + RING_OFF, g, So, E); }
                } SEAM(pb + 2);
            }
            if (KIND(5) && IN(pb + 3)) { REPS(5)  p_attn_odd(P, lds, G); SEAM(pb + 3); }
        }
        if (KIND(6) && IN(pb + 4)) { REPS(6) {
            pg8::Gemm g{MIX, (const bf16*)(ws + (L ? WS_WOUT1 : WS_WOUT0)), M, D, D, D, 64, 32768u, 512u * D}; pg8::StaticOrder So; So.init(M, D, G, (int)blockIdx.x);
            pg8::EpiStore E{MO, D, EPI_SKIP, nullptr, nullptr};
            pg8::gemm_phase<pg8::EpiStore, pg8::StaticOrder, GEMM_ALIGN, GEMM_SP2>(lds + RING_OFF, g, So, E);
            } SEAM(pb + 4);
        }
        if (KIND(7) && IN(pb + 5)) {
            if (L == 0) { for (int rep_ = 0; rep_ <= ((((KREP) >> 7) & 1) ? 4 : 0); ++rep_) p_rowpass<0>(MO, P.x, XB, RS, ng + D, nullptr, G); }
            else p_rowpass<1>(MO, nullptr, XB, RS, ng + D, nullptr, G);
            SEAM(pb + 5); }
        if (KIND(8) && IN(pb + 6)) { {
            pg8::Gemm g{XB, (const bf16*)(ws + WS_WFI) + (size_t)L * FF2 * D, M, FF2, D, D, 64, 32768u, 512u * D}; pg8::StaticOrder So; So.init(M, FF2, G, (int)blockIdx.x);
            pg8::EpiConv E{(bf16*)(ws + WS_G), FF, RS, P.ffn_conv_w + (size_t)L * 3 * FF2, P.ffn_conv_b + (size_t)L * FF2, FF, (float*)(ws + WS_HALO), (LAS float*)(lds + HB_OFF)};
            pg8::gemm_phase<pg8::EpiConv, pg8::StaticOrder, true, GEMM_SP2>(lds + RING_OFF, g, So, E);
            }
            if (IN(pb + 8)) xcd_barrier(bar);
        }
        if (KIND(10) && IN(pb + 8)) { REPS(10) {
            pg8::Gemm g{(const bf16*)(ws + WS_G), (const bf16*)(ws + WS_WFO) + (size_t)L * D * FF, M, D, FF, FF, 64, 32768u, 512u * FF}; pg8::StaticOrder So; So.init(M, D, G, (int)blockIdx.x);
            { pg8::Unit uu; int last = -1;
              for (int i = 0; So.next(i, uu); ++i) if (uu.pm != last && (uu.pm & 15) != 0) { ffn_fixup((const float*)(ws + WS_HALO), P.ffn_conv_w + (size_t)L * 3 * FF2, P.ffn_conv_b + (size_t)L * FF2, (bf16*)(ws + WS_G), uu.pm); last = uu.pm; }
              VM_WAIT(); __syncthreads(); }
            pg8::EpiStore E{MO, D, EPI_SKIP, nullptr, nullptr};
            pg8::gemm_phase<pg8::EpiStore, pg8::StaticOrder, GEMM_ALIGN, GEMM_SP2>(lds + RING_OFF, g, So, E);
            } SEAM(pb + 8);
        }
        if (KIND(11) && IN(pb + 9)) {
            if (L == 0) { p_rowpass<1>(MO, nullptr, XB, RS, ng + 3 * D, nullptr, G); SEAM(pb + 9); }
            else p_rowpass<2>(MO, nullptr, XB, nullptr, ng + 3 * D, P.out, G);
        }
    }
#undef IN
#undef SEAM
}

#ifndef MK_FUSED
#define MK_FUSED 1
#endif
extern "C" void kernel_launch(void* const* d_in, const int* in_sizes, int n_in, void* d_out, int out_size, void* d_ws, size_t ws_size, hipStream_t stream) {
    static int grid = 0;
    if (grid == 0) {
        if (n_in != 17 || in_sizes[0] != M * D || out_size != M * D || ws_size < WS_END) { fprintf(stderr, "kernel_launch: unexpected shapes (n_in %d, in0 %d, out %d, ws %zu)\n", n_in, n_in > 0 ? in_sizes[0] : -1, out_size, ws_size); grid = -1; return; }
        int dev = 0, cus = 0, per_cu = 0;
        if (hipGetDevice(&dev) != hipSuccess || hipDeviceGetAttribute(&cus, hipDeviceAttributeMultiprocessorCount, dev) != hipSuccess) { grid = -1; return; }
        if (hipFuncSetAttribute((const void*)fwd, hipFuncAttributeMaxDynamicSharedMemorySize, LDS_BYTES) != hipSuccess) { fprintf(stderr, "kernel_launch: hipFuncSetAttribute failed\n"); grid = -1; return; }
        if (hipOccupancyMaxActiveBlocksPerMultiprocessor(&per_cu, (const void*)fwd, NWAVES * 64, LDS_BYTES) != hipSuccess || per_cu < 1)
            fprintf(stderr, "kernel_launch: note: occupancy query reports %d workgroups per CU\n", per_cu);
        (void)hipGetLastError();
        grid = cus;
    }
    if (grid < 0) return;
    if (hipMemsetAsync((char*)d_ws + WS_CTL, 0, CTL_ZERO_BYTES, stream) != hipSuccess) { fprintf(stderr, "kernel_launch: memset failed\n"); return; }
    Args a{};
    const float** pp = (const float**)&a.p;
    for (int i = 0; i < 17; ++i) pp[i] = (const float*)d_in[i];
    a.p.out = (float*)d_out; a.p.ws = (unsigned char*)d_ws;
#if MK_FUSED
    a.ph_lo = 0; a.ph_hi = N_PHASES;
    hipLaunchKernelGGL(fwd, dim3(grid), dim3(NWAVES * 64), LDS_BYTES, stream, a);
#else
    for (int ph = 0; ph < N_PHASES; ++ph) {
        if (ph == 3 || ph == 4 || ph == 8 || ph == 18) continue;
        a.ph_lo = ph; a.ph_hi = ph + 1;
        hipLaunchKernelGGL(fwd, dim3(grid), dim3(NWAVES * 64), LDS_BYTES, stream, a);
    }
#endif
}
```

```cpp
#include <hip/hip_runtime.h>
#include <cstdio>
#include <cstdint>
__device__ __forceinline__ int opaque_tid() { int t = threadIdx.x; asm volatile("" : "+v"(t)); return t; }
#ifndef GEMM_ROT
#define GEMM_ROT 0
#endif
#ifndef GEMM_WGM
#define GEMM_WGM 8
#endif
namespace pg8 {
#define PG8_LAS __attribute__((address_space(3)))
typedef unsigned short bf16_t;
typedef short bf16x8 __attribute__((ext_vector_type(8)));
typedef float f32x4 __attribute__((ext_vector_type(4)));
typedef unsigned u32x4 __attribute__((ext_vector_type(4)));
constexpr int BM = 256, BK = 64, HALF = 128, HTB = HALF * BK * 2  , STAGE_BYTES = 8 * HTB, NXCD = 8, WGM = GEMM_WGM;

__host__ __device__ __forceinline__ int lds_byte(int r, int c) { const int st = (r >> 4) * 2 + (c >> 5), rr = r & 15, cc = c & 31, ob = rr * 64 + cc * 2; return st * 1024 + (ob ^ (((ob >> 9) & 1) << 5)); }
__host__ __device__ __forceinline__ void stage_rc(int b, int& R, int& C) { const int st = b / 1024, sb = b % 1024, swz = sb ^ (((sb >> 9) & 1) << 5); R = (st >> 1) * 16 + swz / 64; C = (st & 1) * 32 + (swz % 64) / 2; }
__host__ __device__ __forceinline__ int perm32(int rho) { const int n = rho >> 4, i = rho & 15; return 8 * (i >> 2) + 4 * n + (i & 3); }

struct Unit { int pm, pn; };
struct Gemm { const bf16_t* A; const bf16_t* Bt; int M, N, K, lda, ldb; unsigned kstepB, tstepB; };

struct StaticOrder {
    int nM, nN, nwg, G, c, rot;
    __host__ __device__ __forceinline__ void init(int M, int N, int G_, int c_) { nM = M / BM; nN = N / BM; nwg = nM * nN; G = G_; c = c_; rot = GEMM_ROT ? nN / ((nM + WGM - 1) / WGM) : 0; }
    __host__ __device__ __forceinline__ bool next(int i, Unit& u) const {
        const long L = (long)i * G + c; if (L >= nwg) return false;
        int wgid = (int)L; { const int q = nwg / NXCD, r = nwg % NXCD, xcd = wgid % NXCD, off = wgid / NXCD; wgid = (xcd < r ? xcd * (q + 1) : r * (q + 1) + (xcd - r) * q) + off; }
        const int nig = WGM * nN, gid = wgid / nig, fm = gid * WGM, gsz = (nM - fm) < WGM ? (nM - fm) : WGM;
        u.pm = fm + ((wgid % nig) % gsz); u.pn = ((wgid % nig) / gsz + gid * rot) % nN; return true;
    }
    __device__ __forceinline__ void a_ready(const Unit&) const {}
    __device__ __forceinline__ void done(const Unit&) const {}
};
__device__ __forceinline__ unsigned cvt_pk_bf16(float lo, float hi) { unsigned r; asm volatile("v_cvt_pk_bf16_f32 %0, %1, %2" : "=v"(r) : "v"(lo), "v"(hi)); return r; }
struct EpiStore {
    static constexpr bool PERM = true, AFTER_DRAIN = false;
    bf16_t* O; int ldc; int skip; unsigned* km; const float* rs;
    __device__ __forceinline__ void operator()(const f32x4 (&acc)[2][2][4][2], const Unit& u, int wr, int wc, int fr, int fq) const {
        if (skip) return;
        const int row0 = u.pm * BM + wr * 64 + fr; const int col0 = u.pn * BM + wc * 32 + 8 * fq;
        float scv[2][4];
#pragma unroll
        for (int ai = 0; ai < 2; ++ai)
#pragma unroll
            for (int m = 0; m < 4; ++m) scv[ai][m] = rs ? rs[row0 + ai * HALF + m * 16] : 1.f;
#pragma unroll
        for (int ai = 0; ai < 2; ++ai)
#pragma unroll
            for (int m = 0; m < 4; ++m) { bf16_t* rowp = O + (size_t)(row0 + ai * HALF + m * 16) * ldc + col0;
                const float sc = scv[ai][m];
#pragma unroll
                for (int bj = 0; bj < 2; ++bj) { const f32x4 v0 = acc[ai][bj][m][0] * sc, v1 = acc[ai][bj][m][1] * sc;
                    u32x4 w; w.x = cvt_pk_bf16(v0[0], v0[1]); w.y = cvt_pk_bf16(v0[2], v0[3]); w.z = cvt_pk_bf16(v1[0], v1[1]); w.w = cvt_pk_bf16(v1[2], v1[3]);
                    *(u32x4*)(rowp + bj * HALF) = w; } }
        if (km && u.pn >= 32 && u.pn < 40) {
            float mx[2] = {0.f, 0.f};
#pragma unroll
            for (int ai = 0; ai < 2; ++ai)
#pragma unroll
                for (int m = 0; m < 4; ++m)
#pragma unroll
                    for (int bj = 0; bj < 2; ++bj) { const float sc = scv[ai][m]; const f32x4 v0 = acc[ai][bj][m][0] * sc, v1 = acc[ai][bj][m][1] * sc;
                        const unsigned w0 = cvt_pk_bf16(v0[0], v0[1]), w1 = cvt_pk_bf16(v0[2], v0[3]), w2 = cvt_pk_bf16(v1[0], v1[1]), w3 = cvt_pk_bf16(v1[2], v1[3]);
                        float s = 0.f;
#define SQ2(w) { const float a_ = __uint_as_float((w) << 16), b_ = __uint_as_float((w) & 0xffff0000u); s += a_ * a_ + b_ * b_; }
                        SQ2(w0) SQ2(w1) SQ2(w2) SQ2(w3)
#undef SQ2
                        s += __shfl_xor(s, 16); s += __shfl_xor(s, 32);
                        mx[bj] = fmaxf(mx[bj], s); }
#pragma unroll
            for (int bj = 0; bj < 2; ++bj) { float t = mx[bj]; t = fmaxf(t, __shfl_xor(t, 1)); t = fmaxf(t, __shfl_xor(t, 2)); t = fmaxf(t, __shfl_xor(t, 4)); t = fmaxf(t, __shfl_xor(t, 8));
                if ((threadIdx.x & 63) == 0) atomicMax(km + (((u.pm >> 4) * 16 + (u.pn - 32) * 2 + bj) * 4 + wc), __float_as_uint(t)); }
        }
    }
};


template <int CTRL> __device__ __forceinline__ float dpp1(float x) { return __builtin_bit_cast(float, __builtin_amdgcn_update_dpp(0, __builtin_bit_cast(int, x), CTRL, 0xf, 0xf, false)); }
template <int CTRL> __device__ __forceinline__ float dpp1o(float old, float x) { return __builtin_bit_cast(float, __builtin_amdgcn_update_dpp(__builtin_bit_cast(int, old), __builtin_bit_cast(int, x), CTRL, 0xf, 0xf, false)); }
template <int CTRL> __device__ __forceinline__ f32x4 dpp4o(const f32x4 old, const f32x4 v) { f32x4 r; r.x = dpp1o<CTRL>(old.x, v.x); r.y = dpp1o<CTRL>(old.y, v.y); r.z = dpp1o<CTRL>(old.z, v.z); r.w = dpp1o<CTRL>(old.w, v.w); return r; }
template <int CTRL> __device__ __forceinline__ f32x4 dpp4(const f32x4 v) { f32x4 r; r.x = dpp1<CTRL>(v.x); r.y = dpp1<CTRL>(v.y); r.z = dpp1<CTRL>(v.z); r.w = dpp1<CTRL>(v.w); return r; }
__device__ __forceinline__ float gelu_tanh_f(float x) {
    const float u_ = x * (1.f + 0.044715f * x * x);
    const float e_ = __builtin_amdgcn_exp2f(-2.f * 0.7978845608028654f * 1.4426950408889634f * u_);
    return x * __builtin_amdgcn_rcpf(1.f + e_);
}
struct EpiConv {
    static constexpr bool PERM = true, AFTER_DRAIN = false;
    bf16_t* G; int ldg; const float* rs; const float* cw; const float* cb; int ff; float* halo; PG8_LAS float* hb;
    __device__ __forceinline__ void operator()(const f32x4 (&acc)[2][2][4][2], const Unit& u, int wr, int wc, int fr_in, int fq_in) const {
        int fr = fr_in, fq = fq_in; asm volatile("" : "+v"(fr), "+v"(fq));
        const int R0 = u.pm * BM, rowl0 = wr * 64 + fr;
        float sc[2][4];
#pragma unroll
        for (int ai = 0; ai < 2; ++ai)
#pragma unroll
            for (int m = 0; m < 4; ++m) sc[ai][m] = rs[R0 + ai * HALF + rowl0 + m * 16];
        if (fr >= 14) {
#pragma unroll
            for (int ai = 0; ai < 2; ++ai)
#pragma unroll
                for (int bj = 0; bj < 2; ++bj)
#pragma unroll
                    for (int n = 0; n < 2; ++n) *(PG8_LAS f32x4*)(hb + ((((ai * 2 + wr) * 2 + (fr - 14)) * 2 + bj) * 128 + wc * 32 + fq * 8 + n * 4)) = acc[ai][bj][3][n] * sc[ai][3];
        }
        asm volatile("s_waitcnt lgkmcnt(0)" ::: "memory"); __builtin_amdgcn_s_barrier(); asm volatile("" ::: "memory");
        const int cg0 = u.pn * 128 + wc * 32 + fq * 8;
        const bool skip01 = (u.pm & 15) != 0 && wr == 0;
#pragma unroll
        for (int ai = 0; ai < 2; ++ai) {
            unsigned outp[4][2][2];
#pragma unroll
            for (int n = 0; n < 2; ++n) {
                const int cg = cg0 + 4 * n;
                const f32x4 wg0 = *(const f32x4*)(cw + cg), wg1 = *(const f32x4*)(cw + 2 * ff + cg), wg2 = *(const f32x4*)(cw + 4 * ff + cg), bg = *(const f32x4*)(cb + cg);
                const f32x4 wv0 = *(const f32x4*)(cw + ff + cg), wv1 = *(const f32x4*)(cw + 3 * ff + cg), wv2 = *(const f32x4*)(cw + 5 * ff + cg), bv = *(const f32x4*)(cb + ff + cg);
                f32x4 pg1, pg2, pv1, pv2;
                { f32x4 x14g = {0.f, 0.f, 0.f, 0.f}, x15g = x14g, x14v = x14g, x15v = x14g;
                  if (wr == 1 || ai == 1) { const int pa = wr == 1 ? ai : 0, pw = wr == 1 ? 0 : 1;
                      const PG8_LAS float* h = hb + (((pa * 2 + pw) * 2) * 2) * 128 + wc * 32 + fq * 8 + n * 4;
                      x14g = *(const PG8_LAS f32x4*)(h); x14v = *(const PG8_LAS f32x4*)(h + 128); x15g = *(const PG8_LAS f32x4*)(h + 256); x15v = *(const PG8_LAS f32x4*)(h + 384); }
                  pg1 = x15g; pv1 = x15v;
#pragma unroll
                  for (int k = 0; k < 4; ++k) { pg2[k] = fr == 0 ? x14g[k] : x15g[k]; pv2[k] = fr == 0 ? x14v[k] : x15v[k]; } }
#pragma unroll
                for (int m = 0; m < 4; ++m) {
                    const f32x4 cg_ = acc[ai][0][m][n] * sc[ai][m], cv_ = acc[ai][1][m][n] * sc[ai][m];
                    const f32x4 p1g = dpp4o<0x111>(pg1, cg_), p2g = dpp4o<0x112>(pg2, cg_), p1v = dpp4o<0x111>(pv1, cv_), p2v = dpp4o<0x112>(pv2, cv_);
                    f32x4 o_;
#pragma unroll
                    for (int k = 0; k < 4; ++k) {
                        const float yg = bg[k] + wg0[k] * p2g[k] + wg1[k] * p1g[k] + wg2[k] * cg_[k], yv = bv[k] + wv0[k] * p2v[k] + wv1[k] * p1v[k] + wv2[k] * cv_[k];
                        o_[k] = gelu_tanh_f(yg) * yv; }
                    outp[m][n][0] = cvt_pk_bf16(o_[0], o_[1]); outp[m][n][1] = cvt_pk_bf16(o_[2], o_[3]);
                    if (m < 3) { pg1 = dpp4<0x121>(cg_); pg2 = dpp4<0x122>(cg_); pv1 = dpp4<0x121>(cv_); pv2 = dpp4<0x122>(cv_); }
                }
            }
#pragma unroll
            for (int m = 0; m < 4; ++m) { u32x4 w; w.x = outp[m][0][0]; w.y = outp[m][0][1]; w.z = outp[m][1][0]; w.w = outp[m][1][1];
                if (!(ai == 0 && m == 0 && skip01 && fr < 2)) *(u32x4*)(G + (size_t)(R0 + ai * HALF + rowl0 + m * 16) * ldg + cg0) = w; }
        }
        if (wr == 0 && fr < 2) {
#pragma unroll
            for (int bj = 0; bj < 2; ++bj)
#pragma unroll
                for (int n = 0; n < 2; ++n) *(f32x4*)(halo + (size_t)(u.pm * 4 + fr) * (2 * ff) + bj * ff + cg0 + 4 * n) = acc[0][bj][0][n] * sc[0][0]; }
        if (wr == 1 && fr >= 14) {
#pragma unroll
            for (int bj = 0; bj < 2; ++bj)
#pragma unroll
                for (int n = 0; n < 2; ++n) *(f32x4*)(halo + (size_t)(u.pm * 4 + 2 + (fr - 14)) * (2 * ff) + bj * ff + cg0 + 4 * n) = acc[1][bj][3][n] * sc[1][3]; }
    }
};
template <class Epi, class Sched, bool ALIGN_EPI = false, bool SP2 = false>
__device__ __forceinline__ void gemm_phase(PG8_LAS unsigned char* lds, const Gemm g, const Sched& S, const Epi& E) {
    const int tid = opaque_tid(), wid = __builtin_amdgcn_readfirstlane(tid >> 6), lane = tid & 63, wr = wid >> 2, wc = wid & 3, fr = lane & 15, fq = lane >> 4;
    const int K = g.K, nt = K / BK;
    unsigned voffA[2], voffB[2];
#pragma unroll
    for (int i = 0; i < 2; ++i) { int R, C; stage_rc(tid * 16 + i * 8192, R, C); const int Rb = Epi::PERM ? ((R & ~31) + perm32(R & 31)) : R;
        voffA[i] = (unsigned)(R * g.lda + C) * 2u; voffB[i] = (unsigned)(Rb * g.ldb + C) * 2u; }
    const size_t kstepA = (size_t)(BK * 2), kstepB = (size_t)g.kstepB;
    const size_t hstepA = (size_t)HALF * g.lda * 2, hstepB = (size_t)HALF * g.ldb * 2;
    const size_t tstepA = 2 * hstepA, tstepB = (size_t)g.tstepB;
    const unsigned ldsw = (unsigned)wid * 1024u;
    const int aoff = lds_byte(wr * 64 + fr, fq * 8), boff = lds_byte(wc * 32 + fr, fq * 8);
#define PG8_SA(b, h) (((b) * 2 + (h)) * HTB)
#define PG8_SB(b, h) ((4 + (b) * 2 + (h)) * HTB)
#define PG8_STAGE(bufoff, gbase, voff) do { _Pragma("unroll") for (int _i = 0; _i < 2; ++_i) \
        __builtin_amdgcn_global_load_lds((const unsigned*)((const char*)(gbase) + (voff)[_i]), (PG8_LAS unsigned*)(lds + (bufoff) + ldsw + _i * 8192), 16, 0, 0); } while (0)
#define PG8_LDA(dst, b, h) do { _Pragma("unroll") for (int m = 0; m < 4; ++m) _Pragma("unroll") for (int k = 0; k < 2; ++k) dst[m][k] = *(const PG8_LAS bf16x8*)(lds + PG8_SA(b, h) + aoff + m * 2048 + k * 1024); } while (0)
#define PG8_LDB(dst, b, h) do { _Pragma("unroll") for (int n = 0; n < 2; ++n) _Pragma("unroll") for (int k = 0; k < 2; ++k) dst[n][k] = *(const PG8_LAS bf16x8*)(lds + PG8_SB(b, h) + boff + n * 2048 + k * 1024); } while (0)
#define PG8_MMA(ai, bj, At, Bt) do { __builtin_amdgcn_s_setprio(1); _Pragma("unroll") for (int m = 0; m < 4; ++m) _Pragma("unroll") for (int n = 0; n < 2; ++n) _Pragma("unroll") for (int k = 0; k < 2; ++k) \
        acc[ai][bj][m][n] = __builtin_amdgcn_mfma_f32_16x16x32_bf16(Bt[n][k], At[m][k], acc[ai][bj][m][n], 0, 0, 0); __builtin_amdgcn_s_setprio(0); } while (0)
#define PG8_WAIT_V(n) asm volatile("s_waitcnt vmcnt(" #n ")" ::: "memory")
#define PG8_WAIT_L(n) asm volatile("s_waitcnt lgkmcnt(" #n ")" ::: "memory")
#define PG8_BAR __builtin_amdgcn_s_barrier()
#define PG8_SCHED __builtin_amdgcn_sched_barrier(0)
    Unit cur, nxt; int ui = 0;
    if (!S.next(0, cur)) return;
    f32x4 acc[2][2][4][2];
#pragma unroll
    for (int a = 0; a < 2; ++a)
#pragma unroll
        for (int b = 0; b < 2; ++b)
#pragma unroll
            for (int m = 0; m < 4; ++m)
#pragma unroll
                for (int n = 0; n < 2; ++n) acc[a][b][m][n] = (f32x4){0.f, 0.f, 0.f, 0.f};
    bf16x8 At[4][2], B0[2][2], B1[2][2];
    const char* cA = (const char*)g.A + (size_t)cur.pm * tstepA; const char* cB = (const char*)g.Bt + (size_t)cur.pn * tstepB;
    S.a_ready(cur);
    if constexpr (SP2) {
        PG8_STAGE(PG8_SB(0, 0), cB, voffB); PG8_STAGE(PG8_SB(0, 1), cB + hstepB, voffB); PG8_STAGE(PG8_SA(0, 0), cA, voffA); PG8_STAGE(PG8_SA(0, 1), cA + hstepA, voffA);
        if (wr == 1) PG8_BAR;
        PG8_WAIT_V(2); PG8_BAR;
        PG8_STAGE(PG8_SB(1, 0), cB + kstepB, voffB); PG8_STAGE(PG8_SA(1, 0), cA + kstepA, voffA); PG8_STAGE(PG8_SB(1, 1), cB + hstepB + kstepB, voffB);
        PG8_WAIT_V(6); PG8_BAR;
    } else {
        PG8_STAGE(PG8_SB(0, 0), cB, voffB); PG8_STAGE(PG8_SA(0, 0), cA, voffA); PG8_STAGE(PG8_SB(0, 1), cB + hstepB, voffB); PG8_STAGE(PG8_SA(0, 1), cA + hstepA, voffA);
        if (wr == 1) PG8_BAR;
        PG8_WAIT_V(4); PG8_BAR;
        PG8_STAGE(PG8_SB(1, 0), cB + kstepB, voffB); PG8_STAGE(PG8_SA(1, 0), cA + kstepA, voffA); PG8_STAGE(PG8_SB(1, 1), cB + hstepB + kstepB, voffB);
        PG8_WAIT_V(6); PG8_BAR;
    }
    for (;;) {
        const bool has_next = S.next(ui + 1, nxt);
        const char* nA = has_next ? (const char*)g.A + (size_t)nxt.pm * tstepA : cA; const char* nB = has_next ? (const char*)g.Bt + (size_t)nxt.pn * tstepB : cB;
        for (int t = 0; t < nt; t += 2) {
            const bool last = (t == nt - 2);
            const char* a1 = cA + (size_t)(t + 1) * kstepA;
            const char* a2 = last ? nA : cA + (size_t)(t + 2) * kstepA; const char* b2 = last ? nB : cB + (size_t)(t + 2) * kstepB;
            const char* a3 = a2 + kstepA; const char* b3 = b2 + kstepB;
            if (last && has_next) S.a_ready(nxt);
            if constexpr (SP2) {
            PG8_LDB(B0, 0, 0); PG8_LDB(B1, 0, 1); PG8_SCHED; PG8_LDA(At, 0, 0); PG8_STAGE(PG8_SA(1, 1), a1 + hstepA, voffA);
            PG8_WAIT_V(8); PG8_WAIT_L(0); PG8_BAR; PG8_MMA(0, 0, At, B0); PG8_MMA(0, 1, At, B1); PG8_BAR; PG8_SCHED;
            PG8_LDA(At, 0, 1); PG8_STAGE(PG8_SB(0, 0), b2, voffB); PG8_STAGE(PG8_SB(0, 1), b2 + hstepB, voffB); PG8_STAGE(PG8_SA(0, 0), a2, voffA);
            PG8_WAIT_V(8); PG8_WAIT_L(0); PG8_BAR; PG8_MMA(1, 0, At, B0); PG8_MMA(1, 1, At, B1); PG8_BAR; PG8_SCHED;
            PG8_LDB(B0, 1, 0); PG8_LDB(B1, 1, 1); PG8_SCHED; PG8_LDA(At, 1, 0); PG8_STAGE(PG8_SA(0, 1), a2 + hstepA, voffA);
            PG8_WAIT_V(8); PG8_WAIT_L(0); PG8_BAR; PG8_MMA(0, 0, At, B0); PG8_MMA(0, 1, At, B1); PG8_BAR; PG8_SCHED;
            PG8_LDA(At, 1, 1); PG8_STAGE(PG8_SB(1, 0), b3, voffB); PG8_STAGE(PG8_SB(1, 1), b3 + hstepB, voffB); PG8_STAGE(PG8_SA(1, 0), a3, voffA);
            PG8_WAIT_V(8); PG8_WAIT_L(0); PG8_BAR; PG8_MMA(1, 0, At, B0); PG8_MMA(1, 1, At, B1); PG8_BAR; PG8_SCHED;
            } else {
            PG8_LDB(B0, 0, 0); PG8_SCHED; PG8_LDA(At, 0, 0); PG8_STAGE(PG8_SA(1, 1), a1 + hstepA, voffA);
            PG8_WAIT_L(8); PG8_BAR; PG8_WAIT_L(0); PG8_MMA(0, 0, At, B0); PG8_BAR; PG8_SCHED;
            PG8_LDB(B1, 0, 1); PG8_STAGE(PG8_SB(0, 0), b2, voffB);
            PG8_BAR; PG8_WAIT_L(0); PG8_MMA(0, 1, At, B1); PG8_BAR;
            PG8_LDA(At, 0, 1); PG8_STAGE(PG8_SA(0, 0), a2, voffA);
            PG8_BAR; PG8_WAIT_L(0); PG8_MMA(1, 0, At, B0); PG8_BAR; PG8_SCHED;
            PG8_STAGE(PG8_SB(0, 1), b2 + hstepB, voffB);
            PG8_WAIT_V(6); PG8_BAR; PG8_MMA(1, 1, At, B1); PG8_BAR;
            PG8_LDB(B0, 1, 0); PG8_SCHED; PG8_LDA(At, 1, 0); PG8_STAGE(PG8_SA(0, 1), a2 + hstepA, voffA);
            PG8_WAIT_L(8); PG8_BAR; PG8_WAIT_L(0); PG8_MMA(0, 0, At, B0); PG8_BAR; PG8_SCHED;
            PG8_LDB(B1, 1, 1); PG8_STAGE(PG8_SB(1, 0), b3, voffB);
            PG8_BAR; PG8_WAIT_L(0); PG8_MMA(0, 1, At, B1); PG8_BAR;
            PG8_LDA(At, 1, 1); PG8_STAGE(PG8_SA(1, 0), a3, voffA);
            PG8_BAR; PG8_WAIT_L(0); PG8_MMA(1, 0, At, B0); PG8_BAR; PG8_SCHED;
            PG8_STAGE(PG8_SB(1, 1), b3 + hstepB, voffB);
            PG8_WAIT_V(6); PG8_BAR; PG8_MMA(1, 1, At, B1); PG8_BAR;
            }
        }
        if constexpr (ALIGN_EPI) { if (wr == 0) PG8_BAR; }
        if constexpr (!Epi::AFTER_DRAIN) { E(acc, cur, wr, wc, fr, fq); S.done(cur); }
        if (!has_next) break;
#pragma unroll
        for (int a = 0; a < 2; ++a)
#pragma unroll
            for (int b = 0; b < 2; ++b)
#pragma unroll
                for (int m = 0; m < 4; ++m)
#pragma unroll
                    for (int n = 0; n < 2; ++n) acc[a][b][m][n] = (f32x4){0.f, 0.f, 0.f, 0.f};
        cur = nxt; cA = nA; cB = nB; ++ui;
        if constexpr (ALIGN_EPI) { if (wr == 1) PG8_BAR; }
    }
    PG8_WAIT_V(0);
    if constexpr (!ALIGN_EPI) { if (wr == 0) PG8_BAR; }
    PG8_BAR;
    if constexpr (Epi::AFTER_DRAIN) { E.fused(acc, cur, wr, wc, fr, fq, lds, wid, lane); S.done(cur); }
#undef PG8_SA
#undef PG8_SB
#undef PG8_STAGE
#undef PG8_LDA
#undef PG8_LDB
#undef PG8_MMA
#undef PG8_WAIT_V
#undef PG8_WAIT_L
#undef PG8_BAR
#undef PG8_SCHED
}
}
constexpr int NB = 2, S = 4096, D = 4096, M = NB * S;
constexpr int EVEN_IN = 12288, ODD_IN = 7744, ODD_IN_P = 7936;
constexpr int FF = 11008, FF2 = 22016;
constexpr int QLORA = 1024, KVLORA = 512, QUP_N = 3072, KVUP_N = 4096;
constexpr float EPS = 1e-6f;
constexpr int NWAVES = 8;
constexpr float LOG2E = 1.4426950408889634f, LN2 = 0.6931471805599453f;

#define GAS __attribute__((address_space(1)))
#define LAS __attribute__((address_space(3)))
typedef unsigned short bf16;
typedef unsigned v4u __attribute__((ext_vector_type(4)));
typedef unsigned v2u __attribute__((ext_vector_type(2)));
typedef float f32x4 __attribute__((ext_vector_type(4)));
typedef float f32x16 __attribute__((ext_vector_type(16)));
typedef short bf16x8 __attribute__((ext_vector_type(8)));
typedef short s16x4 __attribute__((ext_vector_type(4)));
#define LDS_WAIT() asm volatile("s_waitcnt lgkmcnt(0)" ::: "memory")
#define VM_WAIT() asm volatile("s_waitcnt vmcnt(0)" ::: "memory")
#define SBAR() __builtin_amdgcn_sched_barrier(0)

constexpr int RING_OFF = 0, RING_BYTES = 131072;
constexpr int SCR_OFF = 131072;
constexpr int AUX_OFF = 133120;
constexpr int FLAG_OFF = 134400;
constexpr int LDSCTL_OFF = 135168, MISC_OFF = LDSCTL_OFF + 64;
constexpr int HB_OFF = 136192;
constexpr int LDS_BYTES = 147456;

__device__ __forceinline__ float wave_sum(float v) {
#pragma unroll
    for (int o = 1; o < 64; o <<= 1) v += __shfl_xor(v, o);
    return v;
}
__device__ __forceinline__ unsigned cvtpk(float lo, float hi) { unsigned r; asm volatile("v_cvt_pk_bf16_f32 %0, %1, %2" : "=v"(r) : "v"(lo), "v"(hi)); return r; }
__device__ __forceinline__ float bflo(unsigned w) { return __uint_as_float(w << 16); }
__device__ __forceinline__ float bfhi(unsigned w) { return __uint_as_float(w & 0xffff0000u); }

namespace att {
constexpr int SHM_T = 16384;
#define KSWZ(row, colB) ((row) * 256 + ((colB) ^ (((row) & 7) << 4)))
#define KSWZ64(row, colB) ((row) * 128 + ((colB) ^ (((row) & 7) << 4)))
__device__ __forceinline__ int v_st(int k, int c) { const int kk = (k & ~0xC) | ((k & 4) << 1) | ((k & 8) >> 1); return ((kk >> 3) * 4 + (c >> 5)) * 512 + ((kk & 7) * 32 + (c & 31)) * 2; }
__device__ __forceinline__ int v_rd_base(int lane) { return ((lane & 3) << 3) | (((lane >> 2) & 3) << 6) | (((lane >> 4) & 1) << 5) | (((lane >> 5) & 1) << 8); }
constexpr int v_rd_off(int d0, int ks, int half) { return d0 * 512 + ks * 4096 + half * 2048; }
__device__ __forceinline__ int crow(int r, int hi) { return (r & 3) + 8 * (r >> 2) + 4 * hi; }

#define MFMA32(a, b, c) __builtin_amdgcn_mfma_f32_32x32x16_bf16((a), (b), (c), 0, 0, 0)

#define DSR128(dst, addr, off) asm volatile("ds_read_b128 %0, %1 offset:%2" : "=&v"(dst) : "v"(addr), "i"(off) : "memory")
#define LGKM(n) asm volatile("s_waitcnt lgkmcnt(" #n ")" ::: "memory")
__device__ __forceinline__ void qkt128(f32x16& p0, f32x16& p1, int kaddr  , int r32, int hi, const bf16x8* qr) {
    int kb[4];
#pragma unroll
    for (int dd = 0; dd < 4; ++dd) kb[dd] = kaddr + KSWZ(r32, (dd * 16 + hi * 8) * 2);
    bf16x8 fa[4], fb[4];
#define QK_ISSUE(F, g) do { DSR128(F[0], kb[(2 * (g)) & 3], ((2 * (g)) >> 2) * 128); DSR128(F[1], kb[(2 * (g)) & 3], ((2 * (g)) >> 2) * 128 + 8192); \
        DSR128(F[2], kb[(2 * (g) + 1) & 3], ((2 * (g) + 1) >> 2) * 128); DSR128(F[3], kb[(2 * (g) + 1) & 3], ((2 * (g) + 1) >> 2) * 128 + 8192); } while (0)
#define QK_MMA(F, g) do { p0 = MFMA32(F[0], qr[2 * (g)], p0); p1 = MFMA32(F[1], qr[2 * (g)], p1); p0 = MFMA32(F[2], qr[2 * (g) + 1], p0); p1 = MFMA32(F[3], qr[2 * (g) + 1], p1); } while (0)
    QK_ISSUE(fa, 0); QK_ISSUE(fb, 1);
    LGKM(4); SBAR(); QK_MMA(fa, 0); SBAR(); QK_ISSUE(fa, 2);
    LGKM(4); SBAR(); QK_MMA(fb, 1); SBAR(); QK_ISSUE(fb, 3);
    LGKM(4); SBAR(); QK_MMA(fa, 2); SBAR();
    LGKM(0); SBAR(); QK_MMA(fb, 3); SBAR();
#undef QK_ISSUE
#undef QK_MMA
}
__device__ __forceinline__ void qkt64(f32x16& p0, f32x16& p1, int kaddr, int r32, int hi, const bf16x8* qr) {
    bf16x8 fa[4], fb[4];
    int ka[4];
#pragma unroll
    for (int d0 = 0; d0 < 4; ++d0) ka[d0] = kaddr + KSWZ64(r32, (d0 * 16 + hi * 8) * 2);
    DSR128(fa[0], ka[0], 0); DSR128(fa[1], ka[0], 4096); DSR128(fa[2], ka[1], 0); DSR128(fa[3], ka[1], 4096);
    DSR128(fb[0], ka[2], 0); DSR128(fb[1], ka[2], 4096); DSR128(fb[2], ka[3], 0); DSR128(fb[3], ka[3], 4096);
    LGKM(4); SBAR();
    p0 = MFMA32(fa[0], qr[0], p0); p1 = MFMA32(fa[1], qr[0], p1); p0 = MFMA32(fa[2], qr[1], p0); p1 = MFMA32(fa[3], qr[1], p1);
    LGKM(0); SBAR();
    p0 = MFMA32(fb[0], qr[2], p0); p1 = MFMA32(fb[1], qr[2], p1); p0 = MFMA32(fb[2], qr[3], p0); p1 = MFMA32(fb[3], qr[3], p1);
    SBAR();
}
__device__ __forceinline__ void pv_tile(f32x16* o, int vb0, bf16x8 pa0, bf16x8 pa1, bf16x8 pa2, bf16x8 pa3) {
#define TRRD(dst, off) asm volatile("ds_read_b64_tr_b16 %0, %1 offset:%2" : "=&v"(dst) : "v"(vb0), "i"(off) : "memory")
    s16x4 A_[8], B_[8];
#define PV_ISSUE(F, d0) do { constexpr int b_ = v_rd_off(d0, 0, 0); TRRD(F[0], b_); TRRD(F[1], b_ + 2048); TRRD(F[2], b_ + 4096); TRRD(F[3], b_ + 6144); \
        TRRD(F[4], b_ + 8192); TRRD(F[5], b_ + 10240); TRRD(F[6], b_ + 12288); TRRD(F[7], b_ + 14336); } while (0)
#define PV_MMA(F, d0) do { \
        o[d0] = MFMA32(pa0, ((bf16x8){F[0][0], F[0][1], F[0][2], F[0][3], F[1][0], F[1][1], F[1][2], F[1][3]}), o[d0]); \
        o[d0] = MFMA32(pa1, ((bf16x8){F[2][0], F[2][1], F[2][2], F[2][3], F[3][0], F[3][1], F[3][2], F[3][3]}), o[d0]); \
        o[d0] = MFMA32(pa2, ((bf16x8){F[4][0], F[4][1], F[4][2], F[4][3], F[5][0], F[5][1], F[5][2], F[5][3]}), o[d0]); \
        o[d0] = MFMA32(pa3, ((bf16x8){F[6][0], F[6][1], F[6][2], F[6][3], F[7][0], F[7][1], F[7][2], F[7][3]}), o[d0]); } while (0)
    PV_ISSUE(A_, 0); PV_ISSUE(B_, 1);
    LGKM(8); SBAR(); PV_MMA(A_, 0); SBAR(); PV_ISSUE(A_, 2);
    LGKM(8); SBAR(); PV_MMA(B_, 1); SBAR(); PV_ISSUE(B_, 3);
    LGKM(8); SBAR(); PV_MMA(A_, 2); SBAR();
    LGKM(0); SBAR(); PV_MMA(B_, 3); SBAR();
#undef PV_ISSUE
#undef PV_MMA
#undef TRRD
}
#define TRRD2(dst, off) asm volatile("ds_read_b64_tr_b16 %0, %1 offset:%2" : "=&v"(dst) : "v"(vb0), "i"(off) : "memory")
#define PV2_ISSUE(F, d0) do { constexpr int b_ = v_rd_off(d0, 0, 0); TRRD2(F[0], b_); TRRD2(F[1], b_ + 2048); TRRD2(F[2], b_ + 4096); TRRD2(F[3], b_ + 6144); \
        TRRD2(F[4], b_ + 8192); TRRD2(F[5], b_ + 10240); TRRD2(F[6], b_ + 12288); TRRD2(F[7], b_ + 14336); } while (0)
#define PV2_MMA(F, d0) do { \
        o[d0] = MFMA32(pa0, ((bf16x8){F[0][0], F[0][1], F[0][2], F[0][3], F[1][0], F[1][1], F[1][2], F[1][3]}), o[d0]); \
        o[d0] = MFMA32(pa1, ((bf16x8){F[2][0], F[2][1], F[2][2], F[2][3], F[3][0], F[3][1], F[3][2], F[3][3]}), o[d0]); \
        o[d0] = MFMA32(pa2, ((bf16x8){F[4][0], F[4][1], F[4][2], F[4][3], F[5][0], F[5][1], F[5][2], F[5][3]}), o[d0]); \
        o[d0] = MFMA32(pa3, ((bf16x8){F[6][0], F[6][1], F[6][2], F[6][3], F[7][0], F[7][1], F[7][2], F[7][3]}), o[d0]); } while (0)
__device__ __forceinline__ void pv_pre(s16x4 (&A_)[8], s16x4 (&B_)[8], int vb0) { PV2_ISSUE(A_, 0); PV2_ISSUE(B_, 1); }
__device__ __forceinline__ void pv_post(f32x16* o, int vb0, bf16x8 pa0, bf16x8 pa1, bf16x8 pa2, bf16x8 pa3, s16x4 (&A_)[8], s16x4 (&B_)[8]) {
    LGKM(8); SBAR(); PV2_MMA(A_, 0); SBAR(); PV2_ISSUE(A_, 2);
    LGKM(8); SBAR(); PV2_MMA(B_, 1); SBAR(); PV2_ISSUE(B_, 3);
    LGKM(8); SBAR(); PV2_MMA(A_, 2); SBAR();
    LGKM(0); SBAR(); PV2_MMA(B_, 3); SBAR();
}
#undef TRRD2
#undef PV2_ISSUE
#undef PV2_MMA
__device__ __forceinline__ float swap_other(float x, int hi) {
    auto rr = __builtin_amdgcn_permlane32_swap(__float_as_uint(x), __float_as_uint(x), false, false);
    return __uint_as_float(hi ? rr[0] : rr[1]);
}
__device__ __forceinline__ void pack_p(const f32x16& p0, const f32x16& p1, bf16x8& pa0, bf16x8& pa1, bf16x8& pa2, bf16x8& pa3) {
#define PK4(P, B_, OUT) do { unsigned a0 = cvtpk(P[B_+0], P[B_+1]), a1 = cvtpk(P[B_+2], P[B_+3]); \
        unsigned b0 = cvtpk(P[B_+4], P[B_+5]), b1 = cvtpk(P[B_+6], P[B_+7]); \
        auto r0 = __builtin_amdgcn_permlane32_swap(a0, b0, false, false); auto r1 = __builtin_amdgcn_permlane32_swap(a1, b1, false, false); \
        v4u w = {r0[0], r1[0], r0[1], r1[1]}; OUT = __builtin_bit_cast(bf16x8, w); } while (0)
    PK4(p0, 0, pa0); PK4(p0, 8, pa1); PK4(p1, 0, pa2); PK4(p1, 8, pa3);
#undef PK4
}
__device__ __forceinline__ void osm(f32x16& p0, f32x16& p1, float& m_reg, float& l_reg, float& alpha, bf16x8& pa0, bf16x8& pa1, bf16x8& pa2, bf16x8& pa3) {
    constexpr float THR2 = 11.5f;
    float pmax = p0[0];
#pragma unroll
    for (int r = 1; r < 16; ++r) pmax = fmaxf(pmax, p0[r]);
#pragma unroll
    for (int r = 0; r < 16; ++r) pmax = fmaxf(pmax, p1[r]);
    { auto rr = __builtin_amdgcn_permlane32_swap(__float_as_uint(pmax), __float_as_uint(pmax), false, false);
      pmax = fmaxf(__uint_as_float(rr[0]), __uint_as_float(rr[1])); }
    float mn;
    if (__all(pmax - m_reg <= THR2)) { mn = m_reg; alpha = 1.f; }
    else { mn = fmaxf(m_reg, pmax); alpha = __builtin_amdgcn_exp2f(m_reg - mn); m_reg = mn; }
    float ps = 0.f;
#pragma unroll
    for (int r = 0; r < 16; ++r) { p0[r] = __builtin_amdgcn_exp2f(p0[r] - mn); ps += p0[r]; }
#pragma unroll
    for (int r = 0; r < 16; ++r) { p1[r] = __builtin_amdgcn_exp2f(p1[r] - mn); ps += p1[r]; }
    { auto rr = __builtin_amdgcn_permlane32_swap(__float_as_uint(ps), __float_as_uint(ps), false, false);
      ps = __uint_as_float(rr[0]) + __uint_as_float(rr[1]); }
    l_reg = l_reg * alpha + ps;
    pack_p(p0, p1, pa0, pa1, pa2, pa3);
}
__device__ __forceinline__ void rescale_o(f32x16* o, float alpha, LAS float* al_l, int r32, int hi) {
    if (__any(alpha < 1.f)) {
        if (hi == 0) al_l[r32] = alpha;
        LDS_WAIT();
#pragma unroll
        for (int r = 0; r < 16; ++r) { const float a = al_l[crow(r, hi)];
#pragma unroll
            for (int d = 0; d < 4; ++d) o[d][r] *= a; }
        LDS_WAIT();
    }
}
__device__ __forceinline__ void store_o(const f32x16* o, bf16* Ow  , int ld, int r32, int hi) {
#pragma unroll
    for (int r = 0; r < 16; ++r) { const int orow = crow(r, hi);
#pragma unroll
        for (int d0 = 0; d0 < 4; ++d0) { const float v = o[d0][r]; const float vn = __shfl_xor(v, 1);
            if ((r32 & 1) == 0) *(unsigned*)(Ow + (size_t)orow * ld + d0 * 32 + r32) = cvtpk(v, vn); } }
}


__device__ __forceinline__ void sb_weights(f32x16& p0, f32x16& p1, float& carry, bool diag, int kb, int tpos, int hi) {
    const float sc_ = 0.08838834764831845f;
    f32x16 L0, L1;
#pragma unroll
    for (int r = 0; r < 16; ++r) {
        float z0 = p0[r] * sc_, z1 = p1[r] * sc_;
        const float e0 = __builtin_amdgcn_exp2f(-fabsf(z0) * LOG2E), e1 = __builtin_amdgcn_exp2f(-fabsf(z1) * LOG2E);
        float l0 = -(fmaxf(z0, 0.f) + __builtin_amdgcn_logf(1.f + e0) * LN2), l1 = -(fmaxf(z1, 0.f) + __builtin_amdgcn_logf(1.f + e1) * LN2);
        if (diag) { const int k0 = kb + crow(r, hi);
            if (k0 >= tpos) { l0 = 0.f; z0 = -__builtin_inff(); }
            if (k0 + 32 >= tpos) { l1 = 0.f; z1 = -__builtin_inff(); } }
        p0[r] = z0; p1[r] = z1; L0[r] = l0; L1[r] = l1;
    }
    float own[8], oth[8], eown[8];
#pragma unroll
    for (int g = 0; g < 4; ++g) {
        L0[4 * g + 2] += L0[4 * g + 3]; L0[4 * g + 1] += L0[4 * g + 2]; L0[4 * g] += L0[4 * g + 1]; own[g] = L0[4 * g];
        L1[4 * g + 2] += L1[4 * g + 3]; L1[4 * g + 1] += L1[4 * g + 2]; L1[4 * g] += L1[4 * g + 1]; own[4 + g] = L1[4 * g];
    }
#pragma unroll
    for (int k = 0; k < 8; ++k) oth[k] = swap_other(own[k], hi);
    float run = carry;
#pragma unroll
    for (int k = 7; k >= 0; --k) {
        const float A_ = hi ? oth[k] : own[k], B_ = hi ? own[k] : oth[k];
        const float eB = run; run += B_; const float eA = run; run += A_;
        eown[k] = hi ? eB : eA;
    }
    carry = run;
#pragma unroll
    for (int r = 0; r < 16; ++r) {
        p0[r] = __builtin_amdgcn_exp2f((p0[r] + L0[r] + eown[r >> 2]) * LOG2E);
        p1[r] = __builtin_amdgcn_exp2f((p1[r] + L1[r] + eown[4 + (r >> 2)]) * LOG2E);
    }
}

enum { MODE_MLA = 0, MODE_CH = 1, MODE_SB = 2 };
struct StdArgs {
    const bf16* Q; int ldq, qcol;
    const bf16* K; int ldk, kcol;
    const bf16* V; int ldv, vcol;
    const bf16* KR;
    const float* TAB;
    const float* bias;
    bf16* O; int ocol;
};
template <int MODE>
__device__ __forceinline__ void std_unit(LAS char* lds, const StdArgs& A, int b, int qb) {
    const int tid = opaque_tid(), wid = __builtin_amdgcn_readfirstlane(tid >> 6), lane = tid & 63, r32 = lane & 31, hi = lane >> 5;
    const int ldsbase = (int)(unsigned)(size_t)lds;
    constexpr int K_OFF = 0, V_OFF = 32768, KR_OFF = 65536;
    LAS float* scr = (LAS float*)(lds + SCR_OFF) + wid * 64; LAS float* li_l = scr; LAS float* al_l = scr + 32;
    const int P0 = qb * 256;
    const size_t rowb = (size_t)b * S;
    const int tpos = P0 + wid * 32 + r32;
    int jstart, jstep, NT, jlo_w;
    const int cw = 4 * qb + (wid >> 1);
    if (MODE == MODE_MLA) { jstart = 0; jstep = 1; NT = 4 * qb + 4; jlo_w = 0; }
    else if (MODE == MODE_CH) { jstart = 4 * qb - 8 < 0 ? 0 : 4 * qb - 8; jstep = 1; NT = 4 * qb + 4 - jstart; jlo_w = cw - 8; }
    else { jstart = 4 * qb + 3; jstep = -1; NT = 4 * qb + 4; jlo_w = 0; }
    constexpr int NQ = (MODE == MODE_MLA) ? 12 : 8;
    bf16x8 qr[NQ];
    { const bf16* qp = A.Q + (rowb + tpos) * (size_t)A.ldq + A.qcol + hi * 8;
#pragma unroll
      for (int d0 = 0; d0 < 8; ++d0) qr[d0] = *(const bf16x8*)(qp + d0 * 16);
      if constexpr (MODE == MODE_MLA) {
          v4u e[4];
#pragma unroll
          for (int k = 0; k < 4; ++k) e[k] = *(const v4u*)(qp + 128 + k * 16);
#pragma unroll
          for (int kk = 0; kk < 2; ++kk) { v4u o1, o2;
#pragma unroll
              for (int w = 0; w < 4; ++w) { const unsigned a = e[kk][w], c = e[kk + 2][w];
                  const int i0 = kk * 16 + hi * 8 + 2 * w;
                  const f32x4 cs = *(const f32x4*)(A.TAB + ((size_t)tpos * 32 + i0) * 2);
                  const float x1a = bflo(a), x1b = bfhi(a), x2a = bflo(c), x2b = bfhi(c);
                  o1[w] = cvtpk(x1a * cs[0] - x2a * cs[1], x1b * cs[2] - x2b * cs[3]);
                  o2[w] = cvtpk(x2a * cs[0] + x1a * cs[1], x2b * cs[2] + x1b * cs[3]); }
              qr[8 + kk] = __builtin_bit_cast(bf16x8, o1); qr[10 + kk] = __builtin_bit_cast(bf16x8, o2); }
      } }
    const int sr = tid >> 4, sc = (tid & 15) * 8;
    const int kws = KSWZ(sr, sc * 2), vst0 = v_st(sr, sc), vst1 = v_st(32 + sr, sc);
    const int rr_r = tid >> 3, rr_c = (tid & 7) * 8, krs = KSWZ64(rr_r, rr_c * 2);
    const bf16* Kg = A.K + rowb * (size_t)A.ldk + A.kcol + sc; const bf16* Vg = A.V + rowb * (size_t)A.ldv + A.vcol + sc;
    const bf16* KRg = A.KR + rowb * 64 + rr_c;
    bf16x8 st_k0, st_k1, st_v0, st_v1, st_r;
#define SLOAD(j) do { const size_t k0_ = (size_t)(j) * 64; \
        st_k0 = *(const bf16x8*)(Kg + (k0_ + sr) * A.ldk); st_k1 = *(const bf16x8*)(Kg + (k0_ + 32 + sr) * A.ldk); \
        st_v0 = *(const bf16x8*)(Vg + (k0_ + sr) * A.ldv); st_v1 = *(const bf16x8*)(Vg + (k0_ + 32 + sr) * A.ldv); \
        if constexpr (MODE == MODE_MLA) st_r = *(const bf16x8*)(KRg + (k0_ + rr_r) * 64); } while (0)
#define SWRITE(bf) do { *(LAS bf16x8*)(lds + K_OFF + (bf) * SHM_T + kws) = st_k0; *(LAS bf16x8*)(lds + K_OFF + (bf) * SHM_T + kws + 32 * 256) = st_k1; \
        *(LAS bf16x8*)(lds + V_OFF + (bf) * SHM_T + vst0) = st_v0; *(LAS bf16x8*)(lds + V_OFF + (bf) * SHM_T + vst1) = st_v1; \
        if constexpr (MODE == MODE_MLA) *(LAS bf16x8*)(lds + KR_OFF + (bf) * 8192 + krs) = st_r; } while (0)
    if constexpr (MODE == MODE_CH) { LAS float* bt = (LAS float*)(lds + AUX_OFF); if (tid < 257) bt[tid] = A.bias[tid] * LOG2E; }
    float m_reg = -1e30f, l_reg = 0.f, carry = 0.f;
    bool wave_done = false;
    f32x16 o[4];
#pragma unroll
    for (int d = 0; d < 4; ++d)
#pragma unroll
        for (int r = 0; r < 16; ++r) o[d][r] = 0.f;
    SLOAD(jstart); VM_WAIT(); SWRITE(0); __syncthreads();
    for (int i = 0; i < NT; ++i) {
        const int j = jstart + i * jstep, bf = i & 1;
        if (i + 1 < NT) SLOAD(j + jstep);
        if (j >= jlo_w && j <= cw && !wave_done) {
            f32x16 p0, p1;
#pragma unroll
            for (int r = 0; r < 16; ++r) { p0[r] = 0.f; p1[r] = 0.f; }
            qkt128(p0, p1, ldsbase + K_OFF + bf * SHM_T, r32, hi, qr);
            if constexpr (MODE == MODE_MLA) qkt64(p0, p1, ldsbase + KR_OFF + bf * 8192, r32, hi, qr + 8);
            bf16x8 pa0, pa1, pa2, pa3;
            if constexpr (MODE == MODE_SB) {
                sb_weights(p0, p1, carry, j == cw, j * 64, tpos, hi);
                pack_p(p0, p1, pa0, pa1, pa2, pa3);
                wave_done = __all(carry < -88.f);
            } else {
                if constexpr (MODE == MODE_MLA) { const float C2 = 0.07216878364870322f * LOG2E;
#pragma unroll
                    for (int r = 0; r < 16; ++r) { p0[r] *= C2; p1[r] *= C2; } }
                else { const float C2 = 0.08838834764831845f * LOG2E; const LAS float* bt = (const LAS float*)(lds + AUX_OFF);
                    if (j <= cw - 3) { const float bc = bt[256];
#pragma unroll
                        for (int r = 0; r < 16; ++r) { p0[r] = p0[r] * C2 + bc; p1[r] = p1[r] * C2 + bc; } }
                    else { const int dq = tpos - j * 64 - 4 * hi + 128;
#pragma unroll
                        for (int r = 0; r < 16; ++r) { const int c = (r & 3) + 8 * (r >> 2);
                            int i0 = dq - c, i1 = dq - c - 32; i0 = i0 < 0 ? 0 : (i0 > 256 ? 256 : i0); i1 = i1 < 0 ? 0 : (i1 > 256 ? 256 : i1);
                            p0[r] = p0[r] * C2 + bt[i0]; p1[r] = p1[r] * C2 + bt[i1]; } } }
                float alpha;
                osm(p0, p1, m_reg, l_reg, alpha, pa0, pa1, pa2, pa3);
                rescale_o(o, alpha, al_l, r32, hi);
            }
            pv_tile(o, ldsbase + V_OFF + bf * SHM_T + v_rd_base(lane), pa0, pa1, pa2, pa3);
        }
        if constexpr (MODE == MODE_SB) { if (lane == 0) ((LAS int*)(lds + FLAG_OFF))[bf * 8 + wid] = wave_done ? 1 : 0; }
        if (i + 1 < NT) { VM_WAIT(); SWRITE(bf ^ 1); }
        __syncthreads();
        if constexpr (MODE == MODE_SB) { const LAS int* fl = (const LAS int*)(lds + FLAG_OFF) + bf * 8; int alld = 1;
#pragma unroll
            for (int w = 0; w < 8; ++w) alld &= fl[w];
            if (alld) break; }
    }
#undef SLOAD
#undef SWRITE
    if constexpr (MODE != MODE_SB) {
        if (hi == 0) li_l[r32] = l_reg;
        LDS_WAIT();
#pragma unroll
        for (int r = 0; r < 16; ++r) { const float rl = __builtin_amdgcn_rcpf(li_l[crow(r, hi)]);
#pragma unroll
            for (int d = 0; d < 4; ++d) o[d][r] *= rl; }
    }
    store_o(o, A.O + (rowb + P0 + wid * 32) * (size_t)D + A.ocol, D, r32, hi);
}

__device__ __forceinline__ void diff_unit(LAS char* lds, const bf16* QKV, const float* gsub, const unsigned* km, float lam, bf16* MIX, int b, int hd, int c) {
    const int tid = opaque_tid(), wid = __builtin_amdgcn_readfirstlane(tid >> 6), lane = tid & 63, r32 = lane & 31, hi = lane >> 5;
    const int ldsbase = (int)(unsigned)(size_t)lds;
    const int s = wid >> 2, v = (wid >> 1) & 1, g = wid & 1;
    LAS float* scr = (LAS float*)(lds + SCR_OFF) + wid * 64; LAS float* li_l = scr; LAS float* al_l = scr + 32;
    const int P0 = c * 64, tpos = P0 + g * 32 + r32; const size_t rowb = (size_t)b * S;
    const float slope2 = __builtin_amdgcn_exp2f(-(float)(hd + 1)) * LOG2E;
    const float C2 = 0.08838834764831845f * LOG2E;
    bf16x8 qr[8];
    { const bf16* qp = QKV + (rowb + tpos) * (size_t)EVEN_IN + 6144 + hd * 256 + s * 128 + hi * 8;
#pragma unroll
      for (int d0 = 0; d0 < 8; ++d0) qr[d0] = *(const bf16x8*)(qp + d0 * 16); }
    float qk2;
    { float ss = 0.f;
#pragma unroll
      for (int d0 = 0; d0 < 8; ++d0) { const v4u w = __builtin_bit_cast(v4u, qr[d0]);
#pragma unroll
          for (int k = 0; k < 4; ++k) { const float a_ = bflo(w[k]), b_ = bfhi(w[k]); ss += a_ * a_ + b_ * b_; } }
      ss += swap_other(ss, hi);
      const unsigned* kp = km + ((b * 16 + hd * 2 + s) * 4);
      const float k2 = __uint_as_float(kp[0]) + __uint_as_float(kp[1]) + __uint_as_float(kp[2]) + __uint_as_float(kp[3]);
      qk2 = sqrtf(ss) * sqrtf(k2) * C2 * 1.001f + 0.01f; }
    const int sr = tid >> 4, sc = (tid & 15) * 8;
    const int kws = KSWZ(sr, sc * 2), vst0 = v_st(sr, sc), vst1 = v_st(32 + sr, sc);
    const bf16* Kg = QKV + rowb * (size_t)EVEN_IN + 8192 + hd * 256 + sc; const bf16* Vg = QKV + rowb * (size_t)EVEN_IN + 10240 + hd * 256 + sc;
    bf16x8 st[8];
#define SLOAD(j) do { const size_t k0_ = (size_t)(j) * 64; const bf16* ka = Kg + (k0_ + sr) * EVEN_IN; const bf16* kb_ = Kg + (k0_ + 32 + sr) * EVEN_IN; \
        const bf16* va = Vg + (k0_ + sr) * EVEN_IN; const bf16* vb_ = Vg + (k0_ + 32 + sr) * EVEN_IN; \
        st[0] = *(const bf16x8*)ka; st[1] = *(const bf16x8*)kb_; st[2] = *(const bf16x8*)(ka + 128); st[3] = *(const bf16x8*)(kb_ + 128); \
        st[4] = *(const bf16x8*)va; st[5] = *(const bf16x8*)vb_; st[6] = *(const bf16x8*)(va + 128); st[7] = *(const bf16x8*)(vb_ + 128); } while (0)
#define SWRITE(bf) do { LAS char* k1 = lds + (bf) * SHM_T; LAS char* k2 = lds + 32768 + (bf) * SHM_T; LAS char* va_ = lds + 65536 + (bf) * SHM_T; LAS char* vb2 = lds + 98304 + (bf) * SHM_T; \
        *(LAS bf16x8*)(k1 + kws) = st[0]; *(LAS bf16x8*)(k1 + kws + 32 * 256) = st[1]; *(LAS bf16x8*)(k2 + kws) = st[2]; *(LAS bf16x8*)(k2 + kws + 32 * 256) = st[3]; \
        *(LAS bf16x8*)(va_ + vst0) = st[4]; *(LAS bf16x8*)(va_ + vst1) = st[5]; *(LAS bf16x8*)(vb2 + vst0) = st[6]; *(LAS bf16x8*)(vb2 + vst1) = st[7]; } while (0)
    float m_reg = -1e30f, l_reg = 0.f;
    f32x16 o[4];
#pragma unroll
    for (int d = 0; d < 4; ++d)
#pragma unroll
        for (int r = 0; r < 16; ++r) o[d][r] = 0.f;
    SLOAD(c); VM_WAIT(); SWRITE(0); __syncthreads();
    for (int i = 0; i <= c; ++i) {
        const int j = c - i, bf = i & 1;
        if (j > 0) SLOAD(j - 1);
        {
            f32x16 p0, p1;
#pragma unroll
            for (int r = 0; r < 16; ++r) { p0[r] = 0.f; p1[r] = 0.f; }
            qkt128(p0, p1, ldsbase + (s * 2 + bf) * SHM_T, r32, hi, qr);
            const float fdq = (float)(tpos - j * 64 - 4 * hi);
#pragma unroll
            for (int r = 0; r < 16; ++r) { const float cr = (float)((r & 3) + 8 * (r >> 2));
                p0[r] = p0[r] * C2 - slope2 * fabsf(fdq - cr); p1[r] = p1[r] * C2 - slope2 * fabsf(fdq - cr - 32.f); }
            bf16x8 pa0, pa1, pa2, pa3; float alpha;
            s16x4 fA[8], fB[8]; const int vb0_ = ldsbase + 65536 + (v * 2 + bf) * SHM_T + v_rd_base(lane);
            pv_pre(fA, fB, vb0_);
            osm(p0, p1, m_reg, l_reg, alpha, pa0, pa1, pa2, pa3);
            rescale_o(o, alpha, al_l, r32, hi);
            pv_post(o, vb0_, pa0, pa1, pa2, pa3, fA, fB);
        }
        { const float ub = qk2 - slope2 * (float)(tpos - (j * 64 - 1));
          const bool stop_w = __all(ub - m_reg < -60.f);
          if (lane == 0) ((LAS int*)(lds + FLAG_OFF))[bf * 8 + wid] = stop_w ? 1 : 0; }
        if (j > 0) { VM_WAIT(); SWRITE(bf ^ 1); }
        __syncthreads();
        { const LAS int* fl = (const LAS int*)(lds + FLAG_OFF) + bf * 8; int alls = 1;
#pragma unroll
          for (int w = 0; w < 8; ++w) alls &= fl[w];
          if (alls) break; }
    }
#undef SLOAD
#undef SWRITE
    if (hi == 0) li_l[r32] = l_reg;
    LDS_WAIT();
#pragma unroll
    for (int r = 0; r < 16; ++r) { const float rl = __builtin_amdgcn_rcpf(li_l[crow(r, hi)]);
#pragma unroll
        for (int d = 0; d < 4; ++d) o[d][r] *= rl; }
    LAS float* EX = (LAS float*)lds;
    if (s == 1) {
#pragma unroll
        for (int d = 0; d < 4; ++d)
#pragma unroll
            for (int r = 0; r < 16; ++r) EX[(((wid - 4) * 4 + d) * 16 + r) * 64 + lane] = o[d][r];
    }
    __syncthreads();
    LAS float* SSQ = (LAS float*)(lds + AUX_OFF);
    if (s == 0) {
#pragma unroll
        for (int d = 0; d < 4; ++d)
#pragma unroll
            for (int r = 0; r < 16; ++r) o[d][r] -= lam * EX[((wid * 4 + d) * 16 + r) * 64 + lane];
#pragma unroll
        for (int r = 0; r < 16; ++r) { float q = o[0][r] * o[0][r] + o[1][r] * o[1][r] + o[2][r] * o[2][r] + o[3][r] * o[3][r];
            q += __shfl_xor(q, 1); q += __shfl_xor(q, 2); q += __shfl_xor(q, 4); q += __shfl_xor(q, 8); q += __shfl_xor(q, 16);
            if (r32 == 0) SSQ[wid * 32 + crow(r, hi)] = q; }
    }
    __syncthreads();
    if (s == 0) {
        float gs[4];
#pragma unroll
        for (int d = 0; d < 4; ++d) gs[d] = gsub[v * 128 + d * 32 + r32] * 0.8f;
#pragma unroll
        for (int r = 0; r < 16; ++r) { const float tot = SSQ[wid * 32 + crow(r, hi)] + SSQ[(wid ^ 2) * 32 + crow(r, hi)];
            const float rstd = rsqrtf(tot * (1.f / 256.f) + EPS);
#pragma unroll
            for (int d = 0; d < 4; ++d) o[d][r] *= rstd * gs[d]; }
        store_o(o, MIX + (rowb + P0 + g * 32) * (size_t)D + 2048 + hd * 256 + v * 128, D, r32, hi);
    }
    __syncthreads();
}
#define ABAR() do { asm volatile("s_waitcnt lgkmcnt(0)" ::: "memory"); __builtin_amdgcn_s_barrier(); asm volatile("" ::: "memory"); } while (0)
template <int MODE>
__device__ __forceinline__ void std_unit_p(LAS char* lds, const StdArgs& A, int b, int qb) {
    const int tid = opaque_tid(), wid = __builtin_amdgcn_readfirstlane(tid >> 6), lane = tid & 63, r32 = lane & 31, hi = lane >> 5;
    const int ldsbase = (int)(unsigned)(size_t)lds;
    constexpr int K_OFF = 0, V_OFF = 32768, KR_OFF = 65536;
    LAS float* scr = (LAS float*)(lds + SCR_OFF) + wid * 64; LAS float* li_l = scr; LAS float* al_l = scr + 32;
    const int P0 = qb * 256; const size_t rowb = (size_t)b * S; const int tpos = P0 + wid * 32 + r32;
    const bool grpB = wid >= 4;
    const int cw = 4 * qb + (wid >> 1);
    int jstart, NT, jlo_w;
    if (MODE == MODE_MLA) { jstart = 0; NT = 4 * qb + 4; jlo_w = 0; }
    else { jstart = 4 * qb - 8 < 0 ? 0 : 4 * qb - 8; NT = 4 * qb + 4 - jstart; jlo_w = cw - 8; }
    constexpr int NQ = (MODE == MODE_MLA) ? 12 : 8;
    bf16x8 qr[NQ];
    { const bf16* qp = A.Q + (rowb + tpos) * (size_t)A.ldq + A.qcol + hi * 8;
#pragma unroll
      for (int d0 = 0; d0 < 8; ++d0) qr[d0] = *(const bf16x8*)(qp + d0 * 16);
      if constexpr (MODE == MODE_MLA) {
          v4u e[4];
#pragma unroll
          for (int k = 0; k < 4; ++k) e[k] = *(const v4u*)(qp + 128 + k * 16);
#pragma unroll
          for (int kk = 0; kk < 2; ++kk) { v4u o1, o2;
#pragma unroll
              for (int w = 0; w < 4; ++w) { const unsigned a = e[kk][w], c = e[kk + 2][w];
                  const int i0 = kk * 16 + hi * 8 + 2 * w;
                  const f32x4 cs = *(const f32x4*)(A.TAB + ((size_t)tpos * 32 + i0) * 2);
                  const float x1a = bflo(a), x1b = bfhi(a), x2a = bflo(c), x2b = bfhi(c);
                  o1[w] = cvtpk(x1a * cs[0] - x2a * cs[1], x1b * cs[2] - x2b * cs[3]);
                  o2[w] = cvtpk(x2a * cs[0] + x1a * cs[1], x2b * cs[2] + x1b * cs[3]); }
              qr[8 + kk] = __builtin_bit_cast(bf16x8, o1); qr[10 + kk] = __builtin_bit_cast(bf16x8, o2); }
      } }
    const int sr = tid >> 4, sc = (tid & 15) * 8;
    const int kws = KSWZ(sr, sc * 2), vst0 = v_st(sr, sc), vst1 = v_st(32 + sr, sc);
    const int rr_r = tid >> 3, rr_c = (tid & 7) * 8, krs = KSWZ64(rr_r, rr_c * 2);
    const bf16* Kg = A.K + rowb * (size_t)A.ldk + A.kcol + sc; const bf16* Vg = A.V + rowb * (size_t)A.ldv + A.vcol + sc;
    const bf16* KRg = A.KR + rowb * 64 + rr_c;
    bf16x8 st_k0, st_k1, st_v0, st_v1, st_r;
#define KLOAD(j) do { const size_t k0_ = (size_t)(j) * 64; st_k0 = *(const bf16x8*)(Kg + (k0_ + sr) * A.ldk); st_k1 = *(const bf16x8*)(Kg + (k0_ + 32 + sr) * A.ldk); \
        if constexpr (MODE == MODE_MLA) st_r = *(const bf16x8*)(KRg + (k0_ + rr_r) * 64); } while (0)
#define VLOAD(j) do { const size_t k0_ = (size_t)(j) * 64; st_v0 = *(const bf16x8*)(Vg + (k0_ + sr) * A.ldv); st_v1 = *(const bf16x8*)(Vg + (k0_ + 32 + sr) * A.ldv); } while (0)
#define KWRITE(bf) do { *(LAS bf16x8*)(lds + K_OFF + (bf) * SHM_T + kws) = st_k0; *(LAS bf16x8*)(lds + K_OFF + (bf) * SHM_T + kws + 32 * 256) = st_k1; \
        if constexpr (MODE == MODE_MLA) *(LAS bf16x8*)(lds + KR_OFF + (bf) * 8192 + krs) = st_r; } while (0)
#define VWRITE(bf) do { *(LAS bf16x8*)(lds + V_OFF + (bf) * SHM_T + vst0) = st_v0; *(LAS bf16x8*)(lds + V_OFF + (bf) * SHM_T + vst1) = st_v1; } while (0)
    if constexpr (MODE == MODE_CH) { LAS float* bt = (LAS float*)(lds + AUX_OFF); if (tid < 257) bt[tid] = A.bias[tid] * LOG2E; }
    float m_reg = -1e30f, l_reg = 0.f;
    f32x16 o[4];
#pragma unroll
    for (int d = 0; d < 4; ++d)
#pragma unroll
        for (int r = 0; r < 16; ++r) o[d][r] = 0.f;
    KLOAD(jstart); KWRITE(0);
    if (NT > 1) KLOAD(jstart + 1);
    VLOAD(jstart);
    ABAR();
    if (grpB) ABAR();
    f32x16 p0, p1; bf16x8 pa0, pa1, pa2, pa3;
    for (int i = 0; i <= NT; ++i) {
        const int j = jstart + i;
        if (i < NT) { if (i + 1 < NT) KWRITE((i + 1) & 1); VWRITE(i & 1); }
        if (i + 2 < NT) KLOAD(j + 2);
        if (i + 1 < NT) VLOAD(j + 1);
        const bool act_prev = i > 0 && (j - 1 >= jlo_w) && (j - 1 <= cw);
        const bool act_cur = i < NT && (j >= jlo_w) && (j <= cw);
        if (act_prev) pv_tile(o, ldsbase + V_OFF + ((i - 1) & 1) * SHM_T + v_rd_base(lane), pa0, pa1, pa2, pa3);
        if (act_cur) {
#pragma unroll
            for (int r = 0; r < 16; ++r) { p0[r] = 0.f; p1[r] = 0.f; }
            qkt128(p0, p1, ldsbase + K_OFF + (i & 1) * SHM_T, r32, hi, qr);
            if constexpr (MODE == MODE_MLA) qkt64(p0, p1, ldsbase + KR_OFF + (i & 1) * 8192, r32, hi, qr + 8);
#ifdef PROBE_DUP_QK
            asm volatile("" : "+v"(p0), "+v"(p1));
#pragma unroll
            for (int r = 0; r < 16; ++r) { p0[r] = 0.f; p1[r] = 0.f; }
            qkt128(p0, p1, ldsbase + K_OFF + (i & 1) * SHM_T, r32, hi, qr);
            if constexpr (MODE == MODE_MLA) qkt64(p0, p1, ldsbase + KR_OFF + (i & 1) * 8192, r32, hi, qr + 8);
#endif
        }
        ABAR();
        if (act_cur) {
            if constexpr (MODE == MODE_MLA) { const float C2 = 0.07216878364870322f * LOG2E;
#pragma unroll
                for (int r = 0; r < 16; ++r) { p0[r] *= C2; p1[r] *= C2; } }
            else { const float C2 = 0.08838834764831845f * LOG2E; const LAS float* bt = (const LAS float*)(lds + AUX_OFF);
                if (j <= cw - 3) { const float bc = bt[256];
#pragma unroll
                    for (int r = 0; r < 16; ++r) { p0[r] = p0[r] * C2 + bc; p1[r] = p1[r] * C2 + bc; } }
                else { const int dq = tpos - j * 64 - 4 * hi + 128;
#pragma unroll
                    for (int r = 0; r < 16; ++r) { const int c = (r & 3) + 8 * (r >> 2);
                        int i0 = dq - c, i1 = dq - c - 32; i0 = i0 < 0 ? 0 : (i0 > 256 ? 256 : i0); i1 = i1 < 0 ? 0 : (i1 > 256 ? 256 : i1);
                        p0[r] = p0[r] * C2 + bt[i0]; p1[r] = p1[r] * C2 + bt[i1]; } } }
            float alpha;
            osm(p0, p1, m_reg, l_reg, alpha, pa0, pa1, pa2, pa3);
            rescale_o(o, alpha, al_l, r32, hi);
        }
        ABAR();
    }
    if (!grpB) ABAR();
#undef KLOAD
#undef VLOAD
#undef KWRITE
#undef VWRITE
    {
      const int tid2 = opaque_tid(), wid2 = __builtin_amdgcn_readfirstlane(tid2 >> 6), lane2 = tid2 & 63, r32b = lane2 & 31, hib = lane2 >> 5;
      LAS float* li2 = (LAS float*)(lds + SCR_OFF) + wid2 * 64;
      if (hib == 0) li2[r32b] = l_reg;
      LDS_WAIT();
#pragma unroll
      for (int r = 0; r < 16; ++r) { const float rl = __builtin_amdgcn_rcpf(li2[crow(r, hib)]);
#pragma unroll
          for (int d = 0; d < 4; ++d) o[d][r] *= rl; }
      store_o(o, A.O + ((size_t)b * S + qb * 256 + wid2 * 32) * (size_t)D + A.ocol, D, r32b, hib); }
}
}
#define XB_TMO      128
#define XB_XCNT(j)  (256  + 64 * (j))
#define XB_XSUB(j)  (1280 + 64 * (j))
#define XB_XGEN(j)  (2304 + 64 * (j))
#define XB_TOP      3328
#define XB_TOPGEN   3392
#define XCD_BAR_WORDS 3456
#define XB_SPIN_CAP (1u << 18)

__device__ __forceinline__ unsigned xb_ld(unsigned* p)              { return __hip_atomic_load(p, __ATOMIC_RELAXED, __HIP_MEMORY_SCOPE_AGENT); }
__device__ __forceinline__ unsigned xb_add(unsigned* p, unsigned v) { return __hip_atomic_fetch_add(p, v, __ATOMIC_RELAXED, __HIP_MEMORY_SCOPE_AGENT); }
__device__ __forceinline__ unsigned xb_xcc_id() { return (unsigned)__builtin_amdgcn_s_getreg((3 << 11) | 20) & 0xFu; }
#define XB_SPIN(cond, bar) do { unsigned _sp = 0; while (cond) { __builtin_amdgcn_s_sleep(1); \
    if ((++_sp & 255u) == 0u) { if (xb_ld(&(bar)[XB_TMO])) break; if (_sp > XB_SPIN_CAP) { atomicAdd(&(bar)[XB_TMO], 1u); break; } } } } while (0)

struct XcdBarrier {
    unsigned* bar; unsigned x;
    volatile LAS unsigned* st;
};

__device__ __forceinline__ XcdBarrier xcd_barrier_post(unsigned* bar, volatile LAS unsigned* st) {
    XcdBarrier b; b.bar = bar; b.x = xb_xcc_id(); b.st = st;
    if (threadIdx.x == 0) (void)xb_add(&bar[XB_XCNT(b.x)], 1u);
    return b;
}
__device__ __forceinline__ void xcd_barrier_complete(unsigned* bar, unsigned x, unsigned& nloc, unsigned& nx) {
    const unsigned G = gridDim.x * gridDim.y * gridDim.z;
    unsigned sum, cnt, mine, sp = 0u;
    for (;;) {
        sum = 0u; cnt = 0u; mine = 0u;
#pragma unroll
        for (unsigned j = 0; j < 16; ++j) { const unsigned c = xb_ld(&bar[XB_XCNT(j)]); sum += c; cnt += (c > 0u) ? 1u : 0u; mine = (j == x) ? c : mine; }
        if (sum == G) break;
        __builtin_amdgcn_s_sleep(1);
        if ((++sp & 255u) == 0u) { if (xb_ld(&bar[XB_TMO])) break; if (sp > XB_SPIN_CAP) { atomicAdd(&bar[XB_TMO], 1u); break; } }
    }
    nloc = mine > 0u ? mine : 1u; nx = cnt > 0u ? cnt : 1u;
}

__device__ __forceinline__ void xcd_barrier(const XcdBarrier& b) {
    asm volatile("s_waitcnt vmcnt(0)" ::: "memory");
    __syncthreads();
    if (threadIdx.x == 0) {
        unsigned* bar = b.bar;
        __builtin_amdgcn_s_waitcnt(0);
        unsigned nloc = b.st[0], nx = b.st[1];
        if (nloc == 0u) { xcd_barrier_complete(bar, b.x, nloc, nx); b.st[0] = nloc; b.st[1] = nx; }
        const unsigned old = xb_add(&bar[XB_XSUB(b.x)], 1u);
        const unsigned gen = old / nloc;
        if (old + 1u == (gen + 1u) * nloc) {
            __builtin_amdgcn_fence(__ATOMIC_RELEASE, "agent");
            asm volatile("s_waitcnt vmcnt(0)" ::: "memory");
            const unsigned og = xb_add(&bar[XB_TOP], 1u);
            const unsigned tg = og / nx;
            if (og + 1u == (tg + 1u) * nx) xb_add(&bar[XB_TOPGEN], 1u);
            else XB_SPIN(xb_ld(&bar[XB_TOPGEN]) == tg, bar);
            __builtin_amdgcn_fence(__ATOMIC_ACQUIRE, "agent");
            xb_add(&bar[XB_XGEN(b.x)], 1u);
            asm volatile("s_waitcnt vmcnt(0)" ::: "memory");
        } else {
            XB_SPIN(xb_ld(&bar[XB_XGEN(b.x)]) == gen, bar);
            __builtin_amdgcn_fence(__ATOMIC_ACQUIRE, "agent");
            asm volatile("s_waitcnt vmcnt(0)" ::: "memory");
        }
    }
    __syncthreads();
}

constexpr size_t MiB = (size_t)1 << 20;
constexpr size_t WS_CTL = 0, CTL_ZERO_BYTES = 1 * MiB;
constexpr size_t WS_TAB = 1 * MiB;
constexpr size_t WS_WIN0 = 2 * MiB;
constexpr size_t WS_WOUT0 = 98 * MiB;
constexpr size_t WS_WIN1 = 130 * MiB;
constexpr size_t WS_WOUT1 = 192 * MiB;
constexpr size_t WS_WUQ = 224 * MiB;
constexpr size_t WS_WUKV = 230 * MiB;
constexpr int LDW = D + 64;
constexpr size_t WS_WFI = 1916 * MiB;
constexpr size_t WS_WFO = 578 * MiB;
constexpr size_t WS_XB = 750 * MiB;
constexpr size_t WS_RS = 814 * MiB;
constexpr size_t WS_QKV = 942 * MiB;
constexpr size_t WS_MIX = 1134 * MiB;
constexpr size_t WS_MO = 1198 * MiB;
constexpr size_t WS_HALO = 1262 * MiB;
constexpr size_t WS_G = 1606 * MiB;
constexpr size_t WS_CQN = 1778 * MiB;
constexpr size_t WS_CKVN = 1794 * MiB;
constexpr size_t WS_KROPE = 1802 * MiB;
constexpr size_t WS_QUP = 1804 * MiB;
constexpr size_t WS_KVUP = 1852 * MiB;
constexpr size_t WS_END = 2268 * MiB;
constexpr int CW_BAR = 4096;
constexpr int CW_KM = 8192;
constexpr int CW_Q = 8448;

__constant__ float INV_FREQ[32] = {1.0f, 0.7498942613601685f, 0.5623413324356079f, 0.4216965138912201f, 0.3162277638912201f, 0.23713737726211548f, 0.17782793939113617f, 0.133352130651474f,
    0.10000000149011612f, 0.07498941570520401f, 0.05623413249850273f, 0.04216965287923813f, 0.03162277489900589f, 0.023713737726211548f, 0.017782794311642647f, 0.01333521492779255f,
    0.009999999776482582f, 0.007498941849917173f, 0.005623413249850273f, 0.0042169648222625256f, 0.003162277629598975f, 0.00237137358635664f, 0.0017782794311642647f, 0.0013335214462131262f,
    0.0010000000474974513f, 0.0007498942431993783f, 0.000562341301701963f, 0.0004216965171508491f, 0.0003162277571391314f, 0.00023713737027719617f, 0.00017782794020604342f, 0.0001333521504420787f};

__device__ __forceinline__ void tr_item(const float* __restrict__ W, int K, int N, bf16* WT, const float* gain  , bool ffperm  , LAS float* scr, int item, int lane) {
    const int nblk = N / 64, kb = item / nblk, nb = item - kb * nblk, k0 = 64 * kb, n0 = 64 * nb;
    const int r4 = lane >> 4, c4 = (lane & 15) * 4;
    const float* src = W + (size_t)(k0 + r4) * N + n0 + c4;
    f32x4 v[16];
#pragma unroll
    for (int i = 0; i < 16; ++i) v[i] = *(const f32x4*)(src + (size_t)(4 * i) * N);
    if (gain) {
#pragma unroll
        for (int i = 0; i < 16; ++i) v[i] *= gain[k0 + 4 * i + r4];
    }
#pragma unroll
    for (int i = 0; i < 16; ++i) { LAS float* d = scr + (4 * i + r4) * 65 + c4; d[0] = v[i][0]; d[1] = v[i][1]; d[2] = v[i][2]; d[3] = v[i][3]; }
    LDS_WAIT(); asm volatile("" ::: "memory");
    const int c = lane & 7;
#pragma unroll
    for (int j = 0; j < 8; ++j) { const int n = (lane >> 3) + 8 * j; const LAS float* s = scr + (8 * c) * 65 + n;
        v4u o; o.x = cvtpk(s[0], s[65]); o.y = cvtpk(s[130], s[195]); o.z = cvtpk(s[260], s[325]); o.w = cvtpk(s[390], s[455]);
        int nd = n0 + n; if (ffperm) { const int hf = nd >= FF ? 1 : 0, nn = nd - hf * FF; nd = (nn >> 7) * 256 + hf * 128 + (nn & 127); }
        *(v4u*)(WT + ((size_t)((nd >> 8) * (K >> 6) + kb) * 256 + (nd & 255)) * 64 + 8 * c) = o; }
    LDS_WAIT(); asm volatile("" ::: "memory");
}
__device__ __forceinline__ void rms_row_bf16(const float* xrow, bf16* orow, float* rs, int lane) {
    f32x4 v[16]; float ss = 0.f;
#pragma unroll
    for (int j = 0; j < 16; ++j) { v[j] = ((const f32x4*)xrow)[lane + 64 * j]; ss += (v[j][0] * v[j][0] + v[j][1] * v[j][1]) + (v[j][2] * v[j][2] + v[j][3] * v[j][3]); }
    const float rstd = rsqrtf(wave_sum(ss) * (1.f / D) + EPS);
    if (lane == 0) *rs = rstd;
#pragma unroll
    for (int j = 0; j < 16; ++j) { v2u w; w.x = cvtpk(v[j][0], v[j][1]); w.y = cvtpk(v[j][2], v[j][3]); ((v2u*)orow)[lane + 64 * j] = w; }
}

struct Ptrs {
    const float *x, *norm_g, *even_w_in, *even_w_out, *diff_lambda, *diff_subln_g, *odd_w_in, *odd_w_out, *ch_rel_bias, *mla_q_norm_g, *mla_w_uq, *mla_kv_norm_g, *mla_w_ukv,
                *ffn_w_in, *ffn_conv_w, *ffn_conv_b, *ffn_w_out;
    float* out; unsigned char* ws;
};

__device__ __forceinline__ void p_prologue(const Ptrs& P, LAS unsigned char* lds, int G) {
    const int tid = opaque_tid(), lane = tid & 63, wave = __builtin_amdgcn_readfirstlane(tid >> 6);
    LAS float* scr = (LAS float*)(lds + wave * 16640);
    const int gw = blockIdx.x * NWAVES + wave, NGW = G * NWAVES;
    unsigned char* ws = P.ws;
    constexpr int I_IN0 = 64 * 192, I_OUT = 64 * 64, I_IN1 = 64 * 121, I_UQ = 16 * 48, I_UKV = 8 * 64, I_FI = 64 * 344, I_FO = 172 * 64;
    constexpr int NITEMS = I_IN0 + 2 * I_OUT + I_IN1 + I_UQ + I_UKV + 2 * I_FI + 2 * I_FO;
    for (int it = gw; it < NITEMS; it += NGW) {
        int r = it; const float* W; bf16* WT; int K, N; const float* gn = nullptr;
        if (r < I_FI) { W = P.ffn_w_in; WT = (bf16*)(ws + WS_WFI); K = D; N = FF2; gn = P.norm_g + 2 * D; }
        else if ((r -= I_FI) < I_FI) { W = P.ffn_w_in + (size_t)D * FF2; WT = (bf16*)(ws + WS_WFI) + (size_t)FF2 * D; K = D; N = FF2; gn = P.norm_g + 6 * D; }
        else if ((r -= I_FI) < I_FO) { W = P.ffn_w_out; WT = (bf16*)(ws + WS_WFO); K = FF; N = D; }
        else if ((r -= I_FO) < I_FO) { W = P.ffn_w_out + (size_t)FF * D; WT = (bf16*)(ws + WS_WFO) + (size_t)D * FF; K = FF; N = D; }
        else if ((r -= I_FO) < I_IN0) { W = P.even_w_in; WT = (bf16*)(ws + WS_WIN0); K = D; N = EVEN_IN; gn = P.norm_g; }
        else if ((r -= I_IN0) < I_OUT) { W = P.even_w_out; WT = (bf16*)(ws + WS_WOUT0); K = D; N = D; }
        else if ((r -= I_OUT) < I_IN1) { W = P.odd_w_in; WT = (bf16*)(ws + WS_WIN1); K = D; N = ODD_IN; gn = P.norm_g + 4 * D; }
        else if ((r -= I_IN1) < I_OUT) { W = P.odd_w_out; WT = (bf16*)(ws + WS_WOUT1); K = D; N = D; }
        else if ((r -= I_OUT) < I_UQ) { W = P.mla_w_uq; WT = (bf16*)(ws + WS_WUQ); K = QLORA; N = QUP_N; }
        else { r -= I_UQ; W = P.mla_w_ukv; WT = (bf16*)(ws + WS_WUKV); K = KVLORA; N = KVUP_N; }
        tr_item(W, K, N, WT, gn, N == FF2, scr, r, lane);
    }
    { bf16* wb = (bf16*)(ws + WS_WIN1); constexpr int PER = (ODD_IN_P - ODD_IN) * 64 * 2 / 16, n16 = (D / 64) * PER;
      for (int i = blockIdx.x * 512 + tid; i < n16; i += G * 512) { const int kt = i / PER, j = i - kt * PER;
          ((v4u*)(wb + ((size_t)((ODD_IN >> 8) * (D / 64) + kt) * 256 + (ODD_IN & 255)) * 64))[j] = (v4u){0u, 0u, 0u, 0u}; } }
    { float* tab = (float*)(ws + WS_TAB);
      for (int i = blockIdx.x * 512 + tid; i < S * 32; i += G * 512) { const int pos = i >> 5, f = i & 31;
          const float ang = (float)pos * INV_FREQ[f];
          double rv = (double)ang * 0.15915494309189535; rv -= __builtin_rint(rv); const float fr = (float)rv;
          tab[2 * i] = __builtin_amdgcn_cosf(fr); tab[2 * i + 1] = __builtin_amdgcn_sinf(fr); } }
    for (int m = gw; m < M; m += NGW) rms_row_bf16(P.x + (size_t)m * D, (bf16*)(ws + WS_XB) + (size_t)m * D, (float*)(ws + WS_RS) + m, lane);
}

template <int MODE>
__device__ __forceinline__ void p_rowpass(const bf16* MO, const float* xf, bf16* XB, float* RS, const float* gpost, float* outf, int G) {
    const int tid = opaque_tid(), lane_ = tid & 63, wave = __builtin_amdgcn_readfirstlane(tid >> 6);
    const int gw = blockIdx.x * NWAVES + wave, NGW = G * NWAVES;
    for (int row = gw; row < M; row += NGW) {
        int lane = lane_; asm volatile("" : "+v"(lane));
        const v4u* mo = (const v4u*)(MO + (size_t)row * D);
        float mv[8][8]; float ss = 0.f;
#pragma unroll
        for (int j = 0; j < 8; ++j) { const v4u w = mo[lane + 64 * j];
#pragma unroll
            for (int k = 0; k < 4; ++k) { mv[j][2 * k] = bflo(w[k]); mv[j][2 * k + 1] = bfhi(w[k]); ss += mv[j][2 * k] * mv[j][2 * k] + mv[j][2 * k + 1] * mv[j][2 * k + 1]; } }
        const float rstd = rsqrtf(wave_sum(ss) * (1.f / D) + EPS);
        float ss2 = 0.f;
#pragma unroll
        for (int j = 0; j < 8; ++j) { const int e = 2 * (lane + 64 * j);
            float xv[8];
            if constexpr (MODE == 0) { const f32x4 a = ((const f32x4*)(xf + (size_t)row * D))[e], c = ((const f32x4*)(xf + (size_t)row * D))[e + 1];
#pragma unroll
                for (int k = 0; k < 4; ++k) { xv[k] = a[k]; xv[4 + k] = c[k]; } }
            else { const v4u w = ((const v4u*)(XB + (size_t)row * D))[lane + 64 * j];
#pragma unroll
                for (int k = 0; k < 4; ++k) { xv[2 * k] = bflo(w[k]); xv[2 * k + 1] = bfhi(w[k]); } }
            const f32x4 g0 = ((const f32x4*)gpost)[e], g1 = ((const f32x4*)gpost)[e + 1];
#pragma unroll
            for (int k = 0; k < 4; ++k) { xv[k] += mv[j][k] * rstd * g0[k]; xv[4 + k] += mv[j][4 + k] * rstd * g1[k]; }
#pragma unroll
            for (int k = 0; k < 8; ++k) ss2 += xv[k] * xv[k];
            if constexpr (MODE == 2) { ((f32x4*)(outf + (size_t)row * D))[e] = (f32x4){xv[0], xv[1], xv[2], xv[3]}; ((f32x4*)(outf + (size_t)row * D))[e + 1] = (f32x4){xv[4], xv[5], xv[6], xv[7]}; }
            else { v4u w; w.x = cvtpk(xv[0], xv[1]); w.y = cvtpk(xv[2], xv[3]); w.z = cvtpk(xv[4], xv[5]); w.w = cvtpk(xv[6], xv[7]); ((v4u*)(XB + (size_t)row * D))[lane + 64 * j] = w; }
            if (j & 1) asm volatile("" ::: "memory"); }
        if constexpr (MODE != 2) { const float rstd2 = rsqrtf(wave_sum(ss2) * (1.f / D) + EPS); if (lane == 0) RS[row] = rstd2; }
    }
}

__device__ __forceinline__ float gelu_tanh(float x) {
    const float u = x * (1.f + 0.044715f * x * x);
    const float e = __builtin_amdgcn_exp2f(-2.f * 0.7978845608028654f * LOG2E * u);
    return x * __builtin_amdgcn_rcpf(1.f + e);
}
__device__ __forceinline__ void unpack8(const v4u w, float* f) {
#pragma unroll
    for (int k = 0; k < 4; ++k) { f[2 * k] = bflo(w[k]); f[2 * k + 1] = bfhi(w[k]); }
}
__device__ __forceinline__ void p_conv(const bf16* U, const float* rs  , const float* cw, const float* cb, bf16* Gm, int G) {
    constexpr int NCG = FF / 8, RUN = 32, NRUN = M / RUN;
    const int gtid = blockIdx.x * 512 + opaque_tid(), nthr = G * 512;
    for (int task = gtid; task < NCG * NRUN; task += nthr) {
        const int cg = task % NCG, run = task / NCG, c0 = cg * 8, r0 = run * RUN;
        float wg[3][8], wv[3][8], bg[8], bv[8];
#pragma unroll
        for (int j = 0; j < 3; ++j)
#pragma unroll
            for (int h = 0; h < 2; ++h) { const f32x4 a = *(const f32x4*)(cw + (size_t)j * FF2 + c0 + 4 * h), b = *(const f32x4*)(cw + (size_t)j * FF2 + FF + c0 + 4 * h);
#pragma unroll
                for (int k = 0; k < 4; ++k) { wg[j][4 * h + k] = a[k]; wv[j][4 * h + k] = b[k]; } }
#pragma unroll
        for (int h = 0; h < 2; ++h) { const f32x4 a = *(const f32x4*)(cb + c0 + 4 * h), b = *(const f32x4*)(cb + FF + c0 + 4 * h);
#pragma unroll
            for (int k = 0; k < 4; ++k) { bg[4 * h + k] = a[k]; bv[4 * h + k] = b[k]; } }
        float g1[8], g2[8], v1[8], v2[8];
        if ((r0 % S) == 0) {
#pragma unroll
            for (int k = 0; k < 8; ++k) { g1[k] = 0.f; g2[k] = 0.f; v1[k] = 0.f; v2[k] = 0.f; }
        } else {
            const bf16* u1 = U + (size_t)(r0 - 1) * FF2 + c0; const bf16* u2 = U + (size_t)(r0 - 2) * FF2 + c0;
            unpack8(*(const v4u*)u1, g1); unpack8(*(const v4u*)(u1 + FF), v1); unpack8(*(const v4u*)u2, g2); unpack8(*(const v4u*)(u2 + FF), v2);
            const float s1 = rs[r0 - 1], s2 = rs[r0 - 2];
#pragma unroll
            for (int k = 0; k < 8; ++k) { g1[k] *= s1; v1[k] *= s1; g2[k] *= s2; v2[k] *= s2; }
        }
#pragma unroll 4
        for (int rr = 0; rr < RUN; ++rr) {
            const bf16* u0 = U + (size_t)(r0 + rr) * FF2 + c0;
            float g0[8], v0[8]; unpack8(*(const v4u*)u0, g0); unpack8(*(const v4u*)(u0 + FF), v0);
            { const float s0 = rs[r0 + rr];
#pragma unroll
              for (int k = 0; k < 8; ++k) { g0[k] *= s0; v0[k] *= s0; } }
            float o[8];
#pragma unroll
            for (int k = 0; k < 8; ++k) { const float yg = bg[k] + wg[0][k] * g2[k] + wg[1][k] * g1[k] + wg[2][k] * g0[k];
                const float yv = bv[k] + wv[0][k] * v2[k] + wv[1][k] * v1[k] + wv[2][k] * v0[k];
                o[k] = gelu_tanh(yg) * yv; g2[k] = g1[k]; g1[k] = g0[k]; v2[k] = v1[k]; v1[k] = v0[k]; }
            v4u w; w.x = cvtpk(o[0], o[1]); w.y = cvtpk(o[2], o[3]); w.z = cvtpk(o[4], o[5]); w.w = cvtpk(o[6], o[7]);
            *(v4u*)(Gm + (size_t)(r0 + rr) * FF + c0) = w;
        }
    }
}

__device__ __forceinline__ void p_mlaprep(const bf16* QKV, const float* gq, const float* gkv, const float* tab, bf16* CQN, bf16* CKVN, bf16* KROPE, int G) {
    const int tid = opaque_tid(), lane = tid & 63, wave = __builtin_amdgcn_readfirstlane(tid >> 6);
    const int gw = blockIdx.x * NWAVES + wave, NGW = G * NWAVES;
    for (int row = gw; row < M; row += NGW) {
        const bf16* base = QKV + (size_t)row * ODD_IN_P;
        { float f[2][8]; float ss = 0.f;
#pragma unroll
          for (int j = 0; j < 2; ++j) { unpack8(((const v4u*)(base + 6144))[lane + 64 * j], f[j]);
#pragma unroll
              for (int k = 0; k < 8; ++k) ss += f[j][k] * f[j][k]; }
          const float rstd = rsqrtf(wave_sum(ss) * (1.f / QLORA) + EPS);
#pragma unroll
          for (int j = 0; j < 2; ++j) { const int e = 2 * (lane + 64 * j); const f32x4 g0 = ((const f32x4*)gq)[e], g1 = ((const f32x4*)gq)[e + 1];
              v4u w; w.x = cvtpk(f[j][0] * rstd * g0[0], f[j][1] * rstd * g0[1]); w.y = cvtpk(f[j][2] * rstd * g0[2], f[j][3] * rstd * g0[3]);
              w.z = cvtpk(f[j][4] * rstd * g1[0], f[j][5] * rstd * g1[1]); w.w = cvtpk(f[j][6] * rstd * g1[2], f[j][7] * rstd * g1[3]);
              ((v4u*)(CQN + (size_t)row * QLORA))[lane + 64 * j] = w; } }
        { float f[8]; float ss = 0.f; unpack8(((const v4u*)(base + 7168))[lane], f);
#pragma unroll
          for (int k = 0; k < 8; ++k) ss += f[k] * f[k];
          const float rstd = rsqrtf(wave_sum(ss) * (1.f / KVLORA) + EPS);
          const int e = 2 * lane; const f32x4 g0 = ((const f32x4*)gkv)[e], g1 = ((const f32x4*)gkv)[e + 1];
          v4u w; w.x = cvtpk(f[0] * rstd * g0[0], f[1] * rstd * g0[1]); w.y = cvtpk(f[2] * rstd * g0[2], f[3] * rstd * g0[3]);
          w.z = cvtpk(f[4] * rstd * g1[0], f[5] * rstd * g1[1]); w.w = cvtpk(f[6] * rstd * g1[2], f[7] * rstd * g1[3]);
          ((v4u*)(CKVN + (size_t)row * KVLORA))[lane] = w; }
        if (lane < 32) { const int pos = row % S; const float x1 = __uint_as_float((unsigned)base[7680 + lane] << 16), x2 = __uint_as_float((unsigned)base[7712 + lane] << 16);
            const float cs = tab[((size_t)pos * 32 + lane) * 2], sn = tab[((size_t)pos * 32 + lane) * 2 + 1];
            const unsigned a = cvtpk(x1 * cs - x2 * sn, 0.f), c = cvtpk(x2 * cs + x1 * sn, 0.f);
            KROPE[(size_t)row * 64 + lane] = (bf16)(a & 0xffffu); KROPE[(size_t)row * 64 + 32 + lane] = (bf16)(c & 0xffffu); }
    }
}


__device__ __forceinline__ void ffn_fixup(const float* halo, const float* cw, const float* cb, bf16* Gm, int pm) {
    const int tid = opaque_tid();
    const float* hF = halo + (size_t)(pm * 4) * FF2; const float* hL = halo + (size_t)((pm - 1) * 4 + 2) * FF2;
    for (int q = tid; q < FF / 4; q += NWAVES * 64) { const int c = 4 * q;
        v2u w0_, w1_;
        f32x4 y0[2], y1[2];
#pragma unroll
        for (int h = 0; h < 2; ++h) { const int cc = c + h * FF;
            const f32x4 u0 = *(const f32x4*)(hF + cc), u1 = *(const f32x4*)(hF + FF2 + cc), m2 = *(const f32x4*)(hL + cc), m1 = *(const f32x4*)(hL + FF2 + cc);
            const f32x4 k0 = *(const f32x4*)(cw + cc), k1 = *(const f32x4*)(cw + FF2 + cc), k2 = *(const f32x4*)(cw + 2 * FF2 + cc), bb = *(const f32x4*)(cb + cc);
            y0[h] = bb + k0 * m2 + k1 * m1 + k2 * u0; y1[h] = bb + k0 * m1 + k1 * u0 + k2 * u1; }
        float o0[4], o1[4];
#pragma unroll
        for (int k = 0; k < 4; ++k) { o0[k] = gelu_tanh(y0[0][k]) * y0[1][k]; o1[k] = gelu_tanh(y1[0][k]) * y1[1][k]; }
        w0_.x = cvtpk(o0[0], o0[1]); w0_.y = cvtpk(o0[2], o0[3]); w1_.x = cvtpk(o1[0], o1[1]); w1_.y = cvtpk(o1[2], o1[3]);
        *(v2u*)(Gm + (size_t)(pm * 256) * FF + c) = w0_; *(v2u*)(Gm + (size_t)(pm * 256 + 1) * FF + c) = w1_; }
}
__device__ __forceinline__ int xcd_item(int L, int N) { return (L & 7) * (N >> 3) + (L >> 3); }
__device__ __forceinline__ void p_attn_even(const Ptrs& P, LAS unsigned char* lds8, int G) {
    LAS char* lds = (LAS char*)lds8;
    const bf16* QKV = (const bf16*)(P.ws + WS_QKV); bf16* MIX = (bf16*)(P.ws + WS_MIX);
    const int lane = opaque_tid() & 63;
    float lam;
    { const float* dl = P.diff_lambda; const float a = dl[lane] * dl[128 + lane] + dl[64 + lane] * dl[192 + lane], c = dl[256 + lane] * dl[384 + lane] + dl[320 + lane] * dl[448 + lane];
      lam = __expf(wave_sum(a)) - __expf(wave_sum(c)) + 0.2f; }
    { const unsigned* km = (const unsigned*)(P.ws + WS_CTL) + CW_KM; unsigned* qh = (unsigned*)(P.ws + WS_CTL) + CW_Q; LAS int* qs = (LAS int*)(lds + FLAG_OFF + 64);
      for (;;) {
          if (threadIdx.x == 0) qs[0] = (int)__hip_atomic_fetch_add(qh, 1u, __ATOMIC_RELAXED, __HIP_MEMORY_SCOPE_AGENT);
          __syncthreads();
          const int u = qs[0];
          __syncthreads();
          if (u >= 1536) break;
          if (u < 1024) { const int c = 63 - (u >> 4), grp = u & 15, b = grp >> 3, hd = grp & 7;
              att::diff_unit(lds, QKV, P.diff_subln_g, km, lam, MIX, b, hd, c); }
          else { const int it = u - 1024, qb = 15 - (it >> 5), grp = it & 31, b = grp >> 4, h = grp & 15;
              att::StdArgs A; A.Q = QKV; A.ldq = EVEN_IN; A.qcol = h * 128; A.K = QKV; A.ldk = EVEN_IN; A.kcol = 2048 + h * 128; A.V = QKV; A.ldv = EVEN_IN; A.vcol = 4096 + h * 128;
              A.KR = nullptr; A.TAB = nullptr; A.bias = nullptr; A.O = MIX; A.ocol = h * 128;
              att::std_unit<att::MODE_SB>(lds, A, b, qb); }
      } }
}
__device__ __forceinline__ void p_attn_odd(const Ptrs& P, LAS unsigned char* lds8, int G) {
    LAS char* lds = (LAS char*)lds8;
    const bf16* QKV = (const bf16*)(P.ws + WS_QKV); bf16* MIX = (bf16*)(P.ws + WS_MIX);
    { unsigned* qh = (unsigned*)(P.ws + WS_CTL) + CW_Q + 64; LAS int* qs = (LAS int*)(lds + FLAG_OFF + 64);
      for (;;) {
          if (threadIdx.x == 0) qs[0] = (int)__hip_atomic_fetch_add(qh, 1u, __ATOMIC_RELAXED, __HIP_MEMORY_SCOPE_AGENT);
          __syncthreads();
          const int u = qs[0];
          __syncthreads();
          if (u >= 768) break;
          if (u < 256) { const int it = xcd_item(u, 256), grp = it >> 3, pr = it & 7, b = grp >> 4, h = grp & 15;
              att::StdArgs A; A.Q = (const bf16*)(P.ws + WS_QUP); A.ldq = QUP_N; A.qcol = h * 192; A.K = (const bf16*)(P.ws + WS_KVUP); A.ldk = KVUP_N; A.kcol = h * 256;
              A.V = A.K; A.ldv = KVUP_N; A.vcol = h * 256 + 128; A.KR = (const bf16*)(P.ws + WS_KROPE); A.TAB = (const float*)(P.ws + WS_TAB); A.bias = nullptr; A.O = MIX; A.ocol = 2048 + h * 128;
              att::std_unit_p<att::MODE_MLA>(lds, A, b, 15 - pr);
              att::std_unit_p<att::MODE_MLA>(lds, A, b, pr); }
          else { const int it = u - 256, qb = 15 - (it >> 5), grp = it & 31, b = grp >> 4, h = grp & 15;
              att::StdArgs A; A.Q = QKV; A.ldq = ODD_IN_P; A.qcol = h * 128; A.K = QKV; A.ldk = ODD_IN_P; A.kcol = 2048 + h * 128; A.V = QKV; A.ldv = ODD_IN_P; A.vcol = 4096 + h * 128;
              A.KR = nullptr; A.TAB = nullptr; A.bias = P.ch_rel_bias + h * 257; A.O = MIX; A.ocol = h * 128;
              att::std_unit_p<att::MODE_CH>(lds, A, b, qb); }
      } }
}

#ifdef PROBE_NULL_EPI
#define EPI_SKIP (rep_ > 0)
#else
#define EPI_SKIP 0
#endif
#ifndef GEMM_ALIGN
#define GEMM_ALIGN false
#endif
#ifndef GEMM_SP2
#define GEMM_SP2 true
#endif
struct Args { Ptrs p; int ph_lo, ph_hi; };
constexpr int N_PHASES = 21;

__global__ void __launch_bounds__(NWAVES * 64, 2) fwd(Args args) {
    extern __shared__ __attribute__((aligned(16))) unsigned char lds_raw[];
    LAS unsigned char* lds = (LAS unsigned char*)lds_raw;
    const Ptrs& P = args.p;
    const int tid = opaque_tid(), G = gridDim.x;
    unsigned char* ws = P.ws;
    for (int u = tid; u < (LDS_BYTES - LDSCTL_OFF) / 4; u += NWAVES * 64) ((LAS unsigned*)(lds + LDSCTL_OFF))[u] = 0u;
    __syncthreads();
    const int lo = args.ph_lo, hi = args.ph_hi;
    const bool fused = (hi - lo) > 1;
    XcdBarrier bar; bar.bar = (unsigned*)(ws + WS_CTL) + CW_BAR; bar.x = 0; bar.st = nullptr;
    if (fused) bar = xcd_barrier_post((unsigned*)(ws + WS_CTL) + CW_BAR, (volatile LAS unsigned*)(lds + MISC_OFF));
#ifndef KMASK
#define KMASK 0xfff
#endif
#define KIND(k) (((KMASK) >> (k)) & 1)
#ifndef KREP
#define KREP 0
#endif
#define REPS(k) for (int rep_ = 0; rep_ <= (((KREP) >> (k)) & 1); ++rep_)
#define IN(k) (lo <= (k) && (k) < hi)
#ifdef PROBE_DOUBLE_BAR
#define SEAM(k) do { if (IN(k) && IN((k) + 1)) { xcd_barrier(bar); xcd_barrier(bar); } } while (0)
#else
#define SEAM(k) do { if (IN(k) && IN((k) + 1)) xcd_barrier(bar); } while (0)
#endif

    if (KIND(0) && IN(0)) { REPS(0)  p_prologue(P, lds, G); SEAM(0); }

    for (int L = 0; L < 2; ++L) {
        const int pb = 1 + 10 * L;
        const float* ng = P.norm_g + (size_t)L * 4 * D;
        bf16* XB = (bf16*)(ws + WS_XB); float* RS = (float*)(ws + WS_RS); bf16* QKV = (bf16*)(ws + WS_QKV); bf16* MIX = (bf16*)(ws + WS_MIX); bf16* MO = (bf16*)(ws + WS_MO);
        if (KIND(1) && IN(pb + 0)) { REPS(1) {
            const int N = L ? ODD_IN_P : EVEN_IN;
            pg8::Gemm g{XB, (const bf16*)(ws + (L ? WS_WIN1 : WS_WIN0)), M, N, D, D, 64, 32768u, 512u * D}; pg8::StaticOrder So; So.init(M, N, G, (int)blockIdx.x);
            pg8::EpiStore E{QKV, N, EPI_SKIP, L ? nullptr : (unsigned*)(ws + WS_CTL) + CW_KM, RS};
            pg8::gemm_phase<pg8::EpiStore, pg8::StaticOrder, GEMM_ALIGN, GEMM_SP2>(lds + RING_OFF, g, So, E);
            } SEAM(pb + 0);
        }
        if (L == 0) {
            if (KIND(2) && IN(pb + 1)) { REPS(2)  p_attn_even(P, lds, G); if (IN(pb + 4)) xcd_barrier(bar); }
        } else {
            if (KIND(3) && IN(pb + 1)) { REPS(3)  p_mlaprep(QKV, P.mla_q_norm_g, P.mla_kv_norm_g, (const float*)(ws + WS_TAB), (bf16*)(ws + WS_CQN), (bf16*)(ws + WS_CKVN), (bf16*)(ws + WS_KROPE), G); SEAM(pb + 1); }
            if (KIND(4) && IN(pb + 2)) { REPS(4) {
                { pg8::Gemm g{(const bf16*)(ws + WS_CQN), (const bf16*)(ws + WS_WUQ), M, QUP_N, QLORA, QLORA, 64, 32768u, 512u * QLORA}; pg8::StaticOrder So; So.init(M, QUP_N, G, (int)blockIdx.x);
                  pg8::EpiStore E{(bf16*)(ws + WS_QUP), QUP_N, EPI_SKIP, nullptr, nullptr};
                  pg8::gemm_phase<pg8::EpiStore, pg8::StaticOrder, GEMM_ALIGN, GEMM_SP2>(lds + RING_OFF, g, So, E); }
                { pg8::Gemm g{(const bf16*)(ws + WS_CKVN), (const bf16*)(ws + WS_WUKV), M, KVUP_N, KVLORA, KVLORA, 64, 32768u, 512u * KVLORA}; pg8::StaticOrder So; So.init(M, KVUP_N, G, (int)blockIdx.x);
                  pg8::EpiStore E{(bf16*)(ws + WS_KVUP), KVUP_N, EPI_SKIP, nullptr, nullptr};
                  pg8::gemm_phase<pg8::EpiStore, pg8::StaticOrder, GEMM_ALIGN, GEMM_SP2>(lds + RING_OFF, g, So, E); }
                } SEAM(pb + 2);
            }
            if (KIND(5) && IN(pb + 3)) { REPS(5)  p_attn_odd(P, lds, G); SEAM(pb + 3); }
        }
        if (KIND(6) && IN(pb + 4)) { REPS(6) {
            pg8::Gemm g{MIX, (const bf16*)(ws + (L ? WS_WOUT1 : WS_WOUT0)), M, D, D, D, 64, 32768u, 512u * D}; pg8::StaticOrder So; So.init(M, D, G, (int)blockIdx.x);
            pg8::EpiStore E{MO, D, EPI_SKIP, nullptr, nullptr};
            pg8::gemm_phase<pg8::EpiStore, pg8::StaticOrder, GEMM_ALIGN, GEMM_SP2>(lds + RING_OFF, g, So, E);
            } SEAM(pb + 4);
        }
        if (KIND(7) && IN(pb + 5)) {
            if (L == 0) { for (int rep_ = 0; rep_ <= ((((KREP) >> 7) & 1) ? 4 : 0); ++rep_) p_rowpass<0>(MO, P.x, XB, RS, ng + D, nullptr, G); }
            else p_rowpass<1>(MO, nullptr, XB, RS, ng + D, nullptr, G);
            SEAM(pb + 5); }
        if (KIND(8) && IN(pb + 6)) { {
            pg8::Gemm g{XB, (const bf16*)(ws + WS_WFI) + (size_t)L * FF2 * D, M, FF2, D, D, 64, 32768u, 512u * D}; pg8::StaticOrder So; So.init(M, FF2, G, (int)blockIdx.x);
            pg8::EpiConv E{(bf16*)(ws + WS_G), FF, RS, P.ffn_conv_w + (size_t)L * 3 * FF2, P.ffn_conv_b + (size_t)L * FF2, FF, (float*)(ws + WS_HALO), (LAS float*)(lds + HB_OFF)};
            pg8::gemm_phase<pg8::EpiConv, pg8::StaticOrder, true, GEMM_SP2>(lds + RING_OFF, g, So, E);
            }
            if (IN(pb + 8)) xcd_barrier(bar);
        }
        if (KIND(10) && IN(pb + 8)) { REPS(10) {
            pg8::Gemm g{(const bf16*)(ws + WS_G), (const bf16*)(ws + WS_WFO) + (size_t)L * D * FF, M, D, FF, FF, 64, 32768u, 512u * FF}; pg8::StaticOrder So; So.init(M, D, G, (int)blockIdx.x);
            { pg8::Unit uu; int last = -1;
              for (int i = 0; So.next(i, uu); ++i) if (uu.pm != last && (uu.pm & 15) != 0) { ffn_fixup((const float*)(ws + WS_HALO), P.ffn_conv_w + (size_t)L * 3 * FF2, P.ffn_conv_b + (size_t)L * FF2, (bf16*)(ws + WS_G), uu.pm); last = uu.pm; }
              VM_WAIT(); __syncthreads(); }
            pg8::EpiStore E{MO, D, EPI_SKIP, nullptr, nullptr};
            pg8::gemm_phase<pg8::EpiStore, pg8::StaticOrder, GEMM_ALIGN, GEMM_SP2>(lds + RING_OFF, g, So, E);
            } SEAM(pb + 8);
        }
        if (KIND(11) && IN(pb + 9)) {
            if (L == 0) { p_rowpass<1>(MO, nullptr, XB, RS, ng + 3 * D, nullptr, G); SEAM(pb + 9); }
            else p_rowpass<2>(MO, nullptr, XB, nullptr, ng + 3 * D, P.out, G);
        }
    }
#undef IN
#undef SEAM
}

#ifndef MK_FUSED
#define MK_FUSED 1
#endif
extern "C" void kernel_launch(void* const* d_in, const int* in_sizes, int n_in, void* d_out, int out_size, void* d_ws, size_t ws_size, hipStream_t stream) {
    static int grid = 0;
    if (grid == 0) {
        if (n_in != 17 || in_sizes[0] != M * D || out_size != M * D || ws_size < WS_END) { fprintf(stderr, "kernel_launch: unexpected shapes (n_in %d, in0 %d, out %d, ws %zu)\n", n_in, n_in > 0 ? in_sizes[0] : -1, out_size, ws_size); grid = -1; return; }
        int dev = 0, cus = 0, per_cu = 0;
        if (hipGetDevice(&dev) != hipSuccess || hipDeviceGetAttribute(&cus, hipDeviceAttributeMultiprocessorCount, dev) != hipSuccess) { grid = -1; return; }
        if (hipFuncSetAttribute((const void*)fwd, hipFuncAttributeMaxDynamicSharedMemorySize, LDS_BYTES) != hipSuccess) { fprintf(stderr, "kernel_launch: hipFuncSetAttribute failed\n"); grid = -1; return; }
        if (hipOccupancyMaxActiveBlocksPerMultiprocessor(&per_cu, (const void*)fwd, NWAVES * 64, LDS_BYTES) != hipSuccess || per_cu < 1)
            fprintf(stderr, "kernel_launch: note: occupancy query reports %d workgroups per CU\n", per_cu);
        (void)hipGetLastError();
        grid = cus;
    }
    if (grid < 0) return;
    if (hipMemsetAsync((char*)d_ws + WS_CTL, 0, CTL_ZERO_BYTES, stream) != hipSuccess) { fprintf(stderr, "kernel_launch: memset failed\n"); return; }
    Args a{};
    const float** pp = (const float**)&a.p;
    for (int i = 0; i < 17; ++i) pp[i] = (const float*)d_in[i];
    a.p.out = (float*)d_out; a.p.ws = (unsigned char*)d_ws;
#if MK_FUSED
    a.ph_lo = 0; a.ph_hi = N_PHASES;
    hipLaunchKernelGGL(fwd, dim3(grid), dim3(NWAVES * 64), LDS_BYTES, stream, a);
#else
    for (int ph = 0; ph < N_PHASES; ++ph) {
        if (ph == 3 || ph == 4 || ph == 8 || ph == 18) continue;
        a.ph_lo = ph; a.ph_hi = ph + 1;
        hipLaunchKernelGGL(fwd, dim3(grid), dim3(NWAVES * 64), LDS_BYTES, stream, a);
    }
#endif
}
```
